# Optimizing an MI355X kernel written in HIP

```python
import math
import jax, jax.numpy as jnp
from jax import lax
import numpy as np

D_MODEL = 1024
BATCH = 4
SEQ = 4096
DEPTH = 2

HEAD_DIM = 64
MIX_WIDTH = D_MODEL
FOURIER_WIDTH = MIX_WIDTH // 2
N_HEADS = (MIX_WIDTH - FOURIER_WIDTH) // HEAD_DIM
N_KV_HEADS = 2
KV_GROUP = N_HEADS // N_KV_HEADS
WINDOW = 128
BLOCK = 128
ROPE_THETA = 10000.0
D_FF = 2816
CONV_WIDTH = 3
EPS = 1e-6
Q_COLS = N_HEADS * HEAD_DIM
KV_COLS = N_KV_HEADS * HEAD_DIM
IN_COLS = FOURIER_WIDTH + Q_COLS + 2 * KV_COLS

kernel_name = "hybrid_fourier_swa_convffn_encoder"


def rmsnorm(x, g):
    xf = x.astype(jnp.float32)
    y = xf * lax.rsqrt(jnp.mean(xf * xf, axis=-1, keepdims=True) + EPS)
    return (y * g.astype(jnp.float32)).astype(x.dtype)


def rope(x):
    s, d = x.shape[1], x.shape[-1]
    inv_freq = 1.0 / (ROPE_THETA ** (jnp.arange(0, d, 2, dtype=jnp.float32) / d))
    ang = jnp.arange(s, dtype=jnp.float32)[:, None] * inv_freq[None, :]
    cos = jnp.cos(ang)[None, :, None, :]
    sin = jnp.sin(ang)[None, :, None, :]
    xf = x.astype(jnp.float32)
    x1, x2 = xf[..., : d // 2], xf[..., d // 2:]
    return jnp.concatenate([x1 * cos - x2 * sin, x2 * cos + x1 * sin], axis=-1).astype(x.dtype)


def fourier_mix(u, w_f, b_f):
    f = jnp.fft.fft2(u.astype(jnp.float32), axes=(1, 2), norm="ortho").real.astype(u.dtype)
    return f @ w_f + b_f


def windowed_gqa(q, k, v, sink):
    b, s, _, d = q.shape
    nb = s // BLOCK
    qb = q.reshape(b, nb, BLOCK, N_KV_HEADS, KV_GROUP, d)
    pad = ((0, 0), (BLOCK, BLOCK), (0, 0), (0, 0))
    kp, vp = jnp.pad(k, pad), jnp.pad(v, pad)
    kb = jnp.concatenate([kp[:, i * BLOCK: i * BLOCK + s].reshape(b, nb, BLOCK, N_KV_HEADS, d) for i in range(3)], axis=2)
    vb = jnp.concatenate([vp[:, i * BLOCK: i * BLOCK + s].reshape(b, nb, BLOCK, N_KV_HEADS, d) for i in range(3)], axis=2)
    scores = jnp.einsum("bnqkgd,bnjkd->bnkgqj", qb, kb).astype(jnp.float32) / math.sqrt(d)
    blk = jnp.arange(nb)[:, None]
    qpos = blk * BLOCK + jnp.arange(BLOCK)[None, :]
    kpos = blk * BLOCK - BLOCK + jnp.arange(3 * BLOCK)[None, :]
    valid = (kpos[:, None, :] >= 0) & (kpos[:, None, :] < s) & (jnp.abs(qpos[:, :, None] - kpos[:, None, :]) <= WINDOW)
    scores = jnp.where(valid[None, :, None, None], scores, jnp.finfo(jnp.float32).min)
    sink_col = jnp.broadcast_to(sink.astype(jnp.float32).reshape(1, 1, N_KV_HEADS, KV_GROUP, 1, 1), scores.shape[:-1] + (1,))
    probs = jax.nn.softmax(jnp.concatenate([scores, sink_col], axis=-1), axis=-1)[..., :-1]
    out = jnp.einsum("bnkgqj,bnjkd->bnqkgd", probs.astype(v.dtype), vb)
    return out.reshape(b, s, N_HEADS * d)


def dwconv_centred(h, w, bias):
    hp = jnp.pad(h, ((0, 0), (1, 1), (0, 0)))
    return hp[:, :-2] * w[0] + hp[:, 1:-1] * w[1] + hp[:, 2:] * w[2] + bias


def setup_inputs(seed: int = 0) -> dict:
    key = jax.random.key(seed)
    ks = jax.random.split(key, 16)
    f32 = jnp.float32
    res_scale = (2.0 * DEPTH) ** -0.5

    def nrm(k, shape, scale):
        return jax.random.normal(k, shape, f32) * scale

    return {
        "x": nrm(ks[0], (BATCH, SEQ, D_MODEL), 1.0),
        "norm1": 1.0 + nrm(ks[1], (DEPTH, D_MODEL), 0.02),
        "w_in": nrm(ks[2], (DEPTH, D_MODEL, IN_COLS), D_MODEL ** -0.5),
        "w_fourier": nrm(ks[3], (DEPTH, FOURIER_WIDTH, FOURIER_WIDTH), FOURIER_WIDTH ** -0.5),
        "b_fourier": nrm(ks[4], (DEPTH, FOURIER_WIDTH), 0.02),
        "q_norm": 1.0 + nrm(ks[5], (DEPTH, HEAD_DIM), 0.02),
        "k_norm": 1.0 + nrm(ks[6], (DEPTH, HEAD_DIM), 0.02),
        "sink": nrm(ks[7], (DEPTH, N_HEADS), 0.5),
        "g_fourier_out": 1.0 + nrm(ks[8], (DEPTH, FOURIER_WIDTH), 0.02),
        "g_attn_out": 1.0 + nrm(ks[9], (DEPTH, Q_COLS), 0.02),
        "w_o": nrm(ks[10], (DEPTH, MIX_WIDTH, D_MODEL), MIX_WIDTH ** -0.5 * res_scale),
        "norm2": 1.0 + nrm(ks[11], (DEPTH, D_MODEL), 0.02),
        "w_up": nrm(ks[12], (DEPTH, D_MODEL, 2 * D_FF), D_MODEL ** -0.5),
        "conv_w": nrm(ks[13], (DEPTH, CONV_WIDTH, 2 * D_FF), CONV_WIDTH ** -0.5),
        "conv_b": nrm(ks[14], (DEPTH, 2 * D_FF), 0.02),
        "w_down": nrm(ks[15], (DEPTH, D_FF, D_MODEL), D_FF ** -0.5 * res_scale),
    }


def reference(x, norm1, w_in, w_fourier, b_fourier, q_norm, k_norm, sink, g_fourier_out, g_attn_out, w_o, norm2, w_up, conv_w, conv_b, w_down):
    b, s, _ = x.shape
    for l in range(DEPTH):
        h = rmsnorm(x, norm1[l])
        p = h @ w_in[l]
        u = p[..., :FOURIER_WIDTH]
        q = p[..., FOURIER_WIDTH:FOURIER_WIDTH + Q_COLS].reshape(b, s, N_HEADS, HEAD_DIM)
        k = p[..., FOURIER_WIDTH + Q_COLS:FOURIER_WIDTH + Q_COLS + KV_COLS].reshape(b, s, N_KV_HEADS, HEAD_DIM)
        v = p[..., FOURIER_WIDTH + Q_COLS + KV_COLS:].reshape(b, s, N_KV_HEADS, HEAD_DIM)

        y_f = fourier_mix(u, w_fourier[l], b_fourier[l])

        q = rope(rmsnorm(q, q_norm[l]))
        k = rope(rmsnorm(k, k_norm[l]))
        y_a = windowed_gqa(q, k, v, sink[l])

        mix = jnp.concatenate([rmsnorm(y_f, g_fourier_out[l]), rmsnorm(y_a, g_attn_out[l])], axis=-1)
        x = x + mix @ w_o[l]

        h = rmsnorm(x, norm2[l])
        up = dwconv_centred(h @ w_up[l], conv_w[l], conv_b[l])
        gate, val = up[..., :D_FF], up[..., D_FF:]
        x = x + (jax.nn.silu(gate) * val) @ w_down[l]
    return x
```

```cpp
#include <hip/hip_runtime.h>
#include <cstdio>
#include <cstdint>
#include <cmath>

namespace nv {
constexpr int D = 1024, BATCH = 4, SEQ = 4096, M = BATCH * SEQ, DEPTH = 2;
constexpr int FW = 512, NH = 8, NKV = 2, HD = 64, QC = 512, KVC = 128, INC = 1280, DFF = 2816, UPC = 5632;
constexpr float EPS = 1e-6f;

template <int AMODE, int BMODE>
__global__ void __launch_bounds__(256) sgemm(const float* __restrict__ A, const float* __restrict__ B, float* C, const float* __restrict__ bias, const float* __restrict__ tab,
                                             int K, int lda, int ldb, int ldc, long sA, long sB, long sC, float alpha, int accum, int mult) {
    __shared__ float As[16][68];
    __shared__ float Bs[16][68];
    const int tid = threadIdx.x, tx = tid & 15, ty = tid >> 4;
    const int m0 = blockIdx.y * 64, n0 = blockIdx.x * 64;
    A += (long)blockIdx.z * sA; B += (long)blockIdx.z * sB; C += (long)blockIdx.z * sC;
    float acc[4][4];
#pragma unroll
    for (int i = 0; i < 4; ++i)
#pragma unroll
        for (int j = 0; j < 4; ++j) acc[i][j] = 0.f;
    const int am = tid >> 2, ak = (tid & 3) * 4;
    const int bk = tid >> 4, bn = (tid & 15) * 4;
    for (int k0 = 0; k0 < K; k0 += 16) {
        float av[4], bv[4];
        if (AMODE == 0) { const float4 t = *(const float4*)(A + (long)(m0 + am) * lda + k0 + ak); av[0] = t.x; av[1] = t.y; av[2] = t.z; av[3] = t.w; }
        else {
#pragma unroll
            for (int j = 0; j < 4; ++j) { const unsigned idx = ((unsigned)(m0 + am) * (unsigned)(k0 + ak + j) * (unsigned)mult + (AMODE == 2 ? 3072u : 0u)) & 4095u; av[j] = tab[idx]; }
        }
        if (BMODE == 0) { const float4 t = *(const float4*)(B + (long)(k0 + bk) * ldb + n0 + bn); bv[0] = t.x; bv[1] = t.y; bv[2] = t.z; bv[3] = t.w; }
        else {
#pragma unroll
            for (int j = 0; j < 4; ++j) { const unsigned idx = ((unsigned)(k0 + bk) * (unsigned)(n0 + bn + j) * (unsigned)mult + (BMODE == 2 ? 3072u : 0u)) & 4095u; bv[j] = tab[idx]; }
        }
        __syncthreads();
#pragma unroll
        for (int j = 0; j < 4; ++j) { As[ak + j][am] = av[j]; Bs[bk][bn + j] = bv[j]; }
        __syncthreads();
#pragma unroll
        for (int kk = 0; kk < 16; ++kk) {
            float a[4], b[4];
#pragma unroll
            for (int i = 0; i < 4; ++i) { a[i] = As[kk][ty * 4 + i]; b[i] = Bs[kk][tx * 4 + i]; }
#pragma unroll
            for (int i = 0; i < 4; ++i)
#pragma unroll
                for (int j = 0; j < 4; ++j) acc[i][j] = fmaf(a[i], b[j], acc[i][j]);
        }
    }
#pragma unroll
    for (int i = 0; i < 4; ++i) {
        float* cp = C + (long)(m0 + ty * 4 + i) * ldc + n0 + tx * 4;
#pragma unroll
        for (int j = 0; j < 4; ++j) {
            float v = alpha * acc[i][j];
            if (bias) v += bias[n0 + tx * 4 + j];
            if (accum) v += cp[j];
            cp[j] = v;
        }
    }
}

__device__ __forceinline__ float wave_sum(float v) {
#pragma unroll
    for (int o = 1; o < 64; o <<= 1) v += __shfl_xor(v, o);
    return v;
}
__device__ __forceinline__ float wave_max(float v) {
#pragma unroll
    for (int o = 1; o < 64; o <<= 1) v = fmaxf(v, __shfl_xor(v, o));
    return v;
}

__global__ void __launch_bounds__(256) rmsnorm_rows(const float* __restrict__ in, int ldi, const float* __restrict__ g, float* out, int ldo, int ooff, int ncols, int rows) {
    const int row = blockIdx.x * 4 + (threadIdx.x >> 6), lane = threadIdx.x & 63;
    if (row >= rows) return;
    const float* ip = in + (long)row * ldi;
    float s = 0.f;
    for (int c = lane; c < ncols; c += 64) { const float v = ip[c]; s += v * v; }
    s = wave_sum(s);
    const float r = 1.0f / sqrtf(s / (float)ncols + EPS);
    float* op = out + (long)row * ldo + ooff;
    for (int c = lane; c < ncols; c += 64) op[c] = ip[c] * r * g[c];
}

__global__ void fill_tab(float* tab, float* rope_cos, float* rope_sin) {
    const int i = blockIdx.x * blockDim.x + threadIdx.x;
    if (i < 4096) tab[i] = (float)cos(2.0 * 3.14159265358979323846 * (double)i / 4096.0);
    if (i < SEQ * 32) {
        const int pos = i >> 5, f = i & 31;
        const float inv_freq = 1.0f / powf(10000.0f, (float)(2 * f) / 64.0f);
        const float ang = (float)pos * inv_freq;
        rope_cos[i] = (float)cos((double)ang); rope_sin[i] = (float)sin((double)ang);
    }
}

__global__ void __launch_bounds__(256) qk_norm_rope(float* p, const float* __restrict__ qn, const float* __restrict__ kn, const float* __restrict__ rc, const float* __restrict__ rs) {
    const int w = blockIdx.x * 4 + (threadIdx.x >> 6), lane = threadIdx.x & 63;
    const int row = w / 10, slot = w % 10;
    if (row >= M) return;
    float* xp = p + (long)row * INC + (slot < 8 ? 512 + 64 * slot : 1024 + 64 * (slot - 8));
    const float g = slot < 8 ? qn[lane] : kn[lane];
    const float v = xp[lane];
    const float ss = wave_sum(v * v);
    const float y = v * (1.0f / sqrtf(ss / 64.0f + EPS)) * g;
    const float yp = __shfl_xor(y, 32);
    const int pos = row % SEQ, f = lane & 31;
    const float c = rc[pos * 32 + f], s = rs[pos * 32 + f];
    xp[lane] = lane < 32 ? y * c - yp * s : y * c + yp * s;
}

__global__ void __launch_bounds__(256) attn_naive(const float* __restrict__ p, const float* __restrict__ sink, float* ya) {
    __shared__ float qs[4][64];
    const int wv = threadIdx.x >> 6, lane = threadIdx.x & 63;
    const int w = blockIdx.x * 4 + wv;
    const int row = w >> 3, h = w & 7, kvh = h >> 2;
    const int b = row / SEQ, i = row % SEQ;
    qs[wv][lane] = p[(long)row * INC + 512 + 64 * h + lane];
    __syncthreads();
    const int lo = max(0, i - 128), hi = min(SEQ - 1, i + 128);
    float sc[5];
    float mx = sink[h];
#pragma unroll
    for (int c = 0; c < 5; ++c) {
        const int j = lo + c * 64 + lane;
        float s = -3.0e38f;
        if (j <= hi) {
            const float* kp = p + (long)(b * SEQ + j) * INC + 1024 + 64 * kvh;
            float d = 0.f;
            for (int e = 0; e < 64; ++e) d = fmaf(qs[wv][e], kp[e], d);
            s = d * 0.125f;
        }
        sc[c] = s; mx = fmaxf(mx, s);
    }
    mx = wave_max(mx);
    float den = 0.f;
#pragma unroll
    for (int c = 0; c < 5; ++c) { const int j = lo + c * 64 + lane; sc[c] = (j <= hi) ? expf(sc[c] - mx) : 0.f; den += sc[c]; }
    den = wave_sum(den) + expf(sink[h] - mx);
    float o = 0.f;
#pragma unroll
    for (int c = 0; c < 5; ++c) {
        for (int jj = 0; jj < 64; ++jj) {
            const int j = lo + c * 64 + jj;
            if (j > hi) break;
            const float pj = __shfl(sc[c], jj);
            o = fmaf(pj, p[(long)(b * SEQ + j) * INC + 1152 + 64 * kvh + lane], o);
        }
    }
    ya[(long)row * QC + 64 * h + lane] = o / den;
}

__global__ void __launch_bounds__(256) conv_act(const float* __restrict__ up, const float* __restrict__ cw, const float* __restrict__ cb, float* act) {
    const long idx = (long)blockIdx.x * 256 + threadIdx.x;
    if (idx >= (long)SEQ * DFF) return;
    const int s = (int)(idx / DFF), c = (int)(idx % DFF);
    float g = cb[c], v = cb[DFF + c];
#pragma unroll
    for (int t = 0; t < 3; ++t) {
        const int ss = s + t - 1;
        if (ss >= 0 && ss < SEQ) { g = fmaf(up[(long)ss * UPC + c], cw[t * UPC + c], g); v = fmaf(up[(long)ss * UPC + DFF + c], cw[t * UPC + DFF + c], v); }
    }
    const float sg = g / (1.0f + expf(-g));
    act[idx] = sg * v;
}
}

extern "C" void kernel_launch(void* const* d_in, const int* in_sizes, int n_in, void* d_out, int out_size, void* d_ws, size_t ws_size, hipStream_t stream) {
    using namespace nv;
    const float* x_in = (const float*)d_in[0];
    const float* norm1 = (const float*)d_in[1];
    const float* w_in = (const float*)d_in[2];
    const float* w_f = (const float*)d_in[3];
    const float* b_f = (const float*)d_in[4];
    const float* q_norm = (const float*)d_in[5];
    const float* k_norm = (const float*)d_in[6];
    const float* sink = (const float*)d_in[7];
    const float* g_f = (const float*)d_in[8];
    const float* g_a = (const float*)d_in[9];
    const float* w_o = (const float*)d_in[10];
    const float* norm2 = (const float*)d_in[11];
    const float* w_up = (const float*)d_in[12];
    const float* conv_w = (const float*)d_in[13];
    const float* conv_b = (const float*)d_in[14];
    const float* w_down = (const float*)d_in[15];
    float* x = (float*)d_out;
    char* ws = (char*)d_ws;
    const size_t MB = 1u << 20;
    float* h = (float*)(ws + 0);
    float* p = (float*)(ws + 64 * MB);
    float* f = (float*)(ws + 144 * MB);
    float* ya = (float*)(ws + 176 * MB);
    float* yf = (float*)(ws + 208 * MB);
    float* tab = (float*)(ws + 240 * MB);
    float* rcos = (float*)(ws + 241 * MB);
    float* rsin = (float*)(ws + 242 * MB);
    float* h2 = (float*)(ws + 0);
    float* upb = (float*)(ws + 64 * MB);
    float* actb = (float*)(ws + 152 * MB);
    if (ws_size < 244 * MB) { fprintf(stderr, "ws too small\n"); return; }

    hipMemcpyAsync(x, x_in, (size_t)M * D * 4, hipMemcpyDeviceToDevice, stream);
    fill_tab<<<(SEQ * 32 + 255) / 256, 256, 0, stream>>>(tab, rcos, rsin);
    const float dft_scale = 1.0f / sqrtf((float)SEQ * (float)FW);
    for (int l = 0; l < DEPTH; ++l) {
        rmsnorm_rows<<<M / 4, 256, 0, stream>>>(x, D, norm1 + l * D, h, D, 0, D, M);
        sgemm<0, 0><<<dim3(INC / 64, M / 64, 1), 256, 0, stream>>>(h, w_in + (size_t)l * D * INC, p, nullptr, tab, D, D, INC, INC, 0, 0, 0, 1.f, 0, 0);
        float* Ach = ya; float* Bch = yf;
        sgemm<0, 1><<<dim3(FW / 64, M / 64, 1), 256, 0, stream>>>(p, nullptr, Ach, nullptr, tab, FW, INC, 0, FW, 0, 0, 0, dft_scale, 0, 8);
        sgemm<0, 2><<<dim3(FW / 64, M / 64, 1), 256, 0, stream>>>(p, nullptr, Bch, nullptr, tab, FW, INC, 0, FW, 0, 0, 0, dft_scale, 0, 8);
        sgemm<1, 0><<<dim3(FW / 64, SEQ / 64, BATCH), 256, 0, stream>>>(nullptr, Ach, f, nullptr, tab, SEQ, 0, FW, FW, 0, (long)SEQ * FW, (long)SEQ * FW, 1.f, 0, 1);
        sgemm<2, 0><<<dim3(FW / 64, SEQ / 64, BATCH), 256, 0, stream>>>(nullptr, Bch, f, nullptr, tab, SEQ, 0, FW, FW, 0, (long)SEQ * FW, (long)SEQ * FW, -1.f, 1, 1);
        sgemm<0, 0><<<dim3(FW / 64, M / 64, 1), 256, 0, stream>>>(f, w_f + (size_t)l * FW * FW, yf, b_f + l * FW, tab, FW, FW, FW, FW, 0, 0, 0, 1.f, 0, 0);
        qk_norm_rope<<<(M * 10) / 4, 256, 0, stream>>>(p, q_norm + l * HD, k_norm + l * HD, rcos, rsin);
        attn_naive<<<(M * 8) / 4, 256, 0, stream>>>(p, sink + l * NH, ya);
        float* mix = h;
        rmsnorm_rows<<<M / 4, 256, 0, stream>>>(yf, FW, g_f + l * FW, mix, D, 0, FW, M);
        rmsnorm_rows<<<M / 4, 256, 0, stream>>>(ya, QC, g_a + l * QC, mix, D, FW, QC, M);
        sgemm<0, 0><<<dim3(D / 64, M / 64, 1), 256, 0, stream>>>(mix, w_o + (size_t)l * D * D, x, nullptr, tab, D, D, D, D, 0, 0, 0, 1.f, 1, 0);
        rmsnorm_rows<<<M / 4, 256, 0, stream>>>(x, D, norm2 + l * D, h2, D, 0, D, M);
        for (int b = 0; b < BATCH; ++b) {
            sgemm<0, 0><<<dim3(UPC / 64, SEQ / 64, 1), 256, 0, stream>>>(h2 + (size_t)b * SEQ * D, w_up + (size_t)l * D * UPC, upb, nullptr, tab, D, D, UPC, UPC, 0, 0, 0, 1.f, 0, 0);
            conv_act<<<(SEQ * DFF + 255) / 256, 256, 0, stream>>>(upb, conv_w + (size_t)l * 3 * UPC, conv_b + (size_t)l * UPC, actb);
            sgemm<0, 0><<<dim3(D / 64, SEQ / 64, 1), 256, 0, stream>>>(actb, w_down + (size_t)l * DFF * D, x + (size_t)b * SEQ * D, nullptr, tab, DFF, DFF, D, D, 0, 0, 0, 1.f, 1, 0);
        }
    }
}
```

```cpp
#include <hip/hip_runtime.h>
#include <cstdio>
#include <cstdint>
#include <cmath>
namespace pg8 {
#define PG8_LAS __attribute__((address_space(3)))
typedef unsigned short bf16_t;
typedef short bf16x8 __attribute__((ext_vector_type(8)));
typedef float f32x4 __attribute__((ext_vector_type(4)));
typedef unsigned u32x4 __attribute__((ext_vector_type(4)));
constexpr int BM = 256, BK = 64, HALF = 128, HTB = HALF * BK * 2  , STAGE_BYTES = 8 * HTB, NXCD = 8, WGM = 8;

__host__ __device__ __forceinline__ int lds_byte(int r, int c) { const int st = (r >> 4) * 2 + (c >> 5), rr = r & 15, cc = c & 31, ob = rr * 64 + cc * 2; return st * 1024 + (ob ^ (((ob >> 9) & 1) << 5)); }
__host__ __device__ __forceinline__ void stage_rc(int b, int& R, int& C) { const int st = b / 1024, sb = b % 1024, swz = sb ^ (((sb >> 9) & 1) << 5); R = (st >> 1) * 16 + swz / 64; C = (st & 1) * 32 + (swz % 64) / 2; }
__host__ __device__ __forceinline__ int perm32(int rho) { const int n = rho >> 4, i = rho & 15; return 8 * (i >> 2) + 4 * n + (i & 3); }

struct Unit { int pm, pn; };
struct Gemm { const bf16_t* A; const bf16_t* Bt; int M, N, K; };

struct StaticOrder {
    int nM, nN, nwg, G, c;
    __host__ __device__ void init(int M, int N, int G_, int c_) { nM = M / BM; nN = N / BM; nwg = nM * nN; G = G_; c = c_; }
    __host__ __device__ bool next(int i, Unit& u) const {
        const long L = (long)i * G + c; if (L >= nwg) return false;
        int wgid = (int)L; { const int q = nwg / NXCD, r = nwg % NXCD, xcd = wgid % NXCD, off = wgid / NXCD; wgid = (xcd < r ? xcd * (q + 1) : r * (q + 1) + (xcd - r) * q) + off; }
        const int nig = WGM * nN, gid = wgid / nig, fm = gid * WGM, gsz = (nM - fm) < WGM ? (nM - fm) : WGM;
        u.pm = fm + ((wgid % nig) % gsz); u.pn = (wgid % nig) / gsz; return true;
    }
    __device__ __forceinline__ void a_ready(const Unit&) const {}
    __device__ __forceinline__ void done(const Unit&) const {}
};


typedef float f32x2_t __attribute__((ext_vector_type(2))); typedef __bf16 bf16x2_t __attribute__((ext_vector_type(2)));
__device__ __forceinline__ unsigned cvtpk(float lo, float hi) { f32x2_t v = {lo, hi}; bf16x2_t b = __builtin_convertvector(v, bf16x2_t); return __builtin_bit_cast(unsigned, b); }
__device__ __forceinline__ u32x4 pack8(const f32x4 a, const f32x4 b) { u32x4 w; w.x = cvtpk(a[0], a[1]); w.y = cvtpk(a[2], a[3]); w.z = cvtpk(b[0], b[1]); w.w = cvtpk(b[2], b[3]); return w; }
__device__ __forceinline__ float dot4(const f32x4 a) { return (a[0] * a[0] + a[1] * a[1]) + (a[2] * a[2] + a[3] * a[3]); }
__device__ __forceinline__ float sum16(const float* p) { const f32x4 a = *(const f32x4*)p, b = *(const f32x4*)(p + 4), c = *(const f32x4*)(p + 8), d = *(const f32x4*)(p + 12);
    return (((a[0] + a[1]) + (a[2] + a[3])) + ((b[0] + b[1]) + (b[2] + b[3]))) + (((c[0] + c[1]) + (c[2] + c[3])) + ((d[0] + d[1]) + (d[2] + d[3]))); }
constexpr float RMS_EPS = 1e-6f;
__device__ __forceinline__ float rstd_of(float ss, float inv_n) { return 1.0f / sqrtf(ss * inv_n + RMS_EPS); }

struct EpiIn {
    static constexpr bool PERM = true, AFTER_DRAIN = false, HAS_MID = false;
    bf16_t *U, *Q, *Kb, *Vb; const float* SSX; const float* ropec; const float* ropes; const float* qg; const float* kg; float qscale; int mid_t;
    __device__ __forceinline__ void mid(f32x4 (&)[2][2][4][2], const Unit&, int, int, int, int) const {}
    __device__ __forceinline__ void operator()(const f32x4 (&acc)[2][2][4][2], const Unit& u, int wr, int wc, int fr, int fq) const {
        const int row0 = u.pm * BM + wr * 64 + fr;
        if (u.pn < 2) {
            const int col0 = u.pn * BM + wc * 32 + 8 * fq;
#pragma unroll
            for (int ai = 0; ai < 2; ++ai)
#pragma unroll
                for (int m = 0; m < 4; ++m) { const int row = row0 + ai * HALF + m * 16; const float s = rstd_of(sum16(SSX + (size_t)row * 16), 1.0f / 1024.0f);
#pragma unroll
                    for (int bj = 0; bj < 2; ++bj) *(u32x4*)(U + (size_t)row * 512 + col0 + bj * HALF) = pack8(acc[ai][bj][m][0] * s, acc[ai][bj][m][1] * s); }
        } else {
            const int slot = 4 * (u.pn - 2) + wc;
            if (slot >= 10) {
#pragma unroll
                for (int ai = 0; ai < 2; ++ai)
#pragma unroll
                    for (int m = 0; m < 4; ++m) { const int row = row0 + ai * HALF + m * 16; const float s = rstd_of(sum16(SSX + (size_t)row * 16), 1.0f / 1024.0f);
#pragma unroll
                        for (int bj = 0; bj < 2; ++bj) *(u32x4*)(Vb + (size_t)row * 128 + 64 * (slot - 10) + 32 * bj + 8 * fq) = pack8(acc[ai][bj][m][0] * s, acc[ai][bj][m][1] * s); }
            } else {
                const bool isq = slot < 8; const float* gp = isq ? qg : kg;
                f32x4 g[2][2];
#pragma unroll
                for (int bj = 0; bj < 2; ++bj)
#pragma unroll
                    for (int n = 0; n < 2; ++n) g[bj][n] = *(const f32x4*)(gp + 32 * bj + 8 * fq + 4 * n);
                bf16_t* dst = isq ? (Q + 64 * slot) : (Kb + 64 * (slot - 8)); const int ld = isq ? 512 : 128; const float osc = isq ? qscale : 1.0f;
#pragma unroll
                for (int ai = 0; ai < 2; ++ai)
#pragma unroll
                    for (int m = 0; m < 4; ++m) { const int row = row0 + ai * HALF + m * 16; const float s = rstd_of(sum16(SSX + (size_t)row * 16), 1.0f / 1024.0f);
                        f32x4 y[2][2]; float ss = 0.f;
#pragma unroll
                        for (int bj = 0; bj < 2; ++bj)
#pragma unroll
                            for (int n = 0; n < 2; ++n) { y[bj][n] = acc[ai][bj][m][n] * s; ss += dot4(y[bj][n]); }
                        ss += __shfl_xor(ss, 16); ss += __shfl_xor(ss, 32);
                        const float rn = rstd_of(ss, 1.0f / 64.0f);
                        const int pos = row & 4095;
                        f32x4 o1[2], o2[2];
#pragma unroll
                        for (int n = 0; n < 2; ++n) { const f32x4 c = *(const f32x4*)(ropec + pos * 32 + 8 * fq + 4 * n), sn = *(const f32x4*)(ropes + pos * 32 + 8 * fq + 4 * n);
                            const f32x4 y1 = y[0][n] * rn * g[0][n], y2 = y[1][n] * rn * g[1][n];
                            o1[n] = (y1 * c - y2 * sn) * osc; o2[n] = (y2 * c + y1 * sn) * osc; }
                        *(u32x4*)(dst + (size_t)row * ld + 8 * fq) = pack8(o1[0], o1[1]);
                        *(u32x4*)(dst + (size_t)row * ld + 32 + 8 * fq) = pack8(o2[0], o2[1]); }
            }
        }
    }
};

template <bool RSCALE, bool BIAS, bool SSQ> struct EpiStd {
    static constexpr bool PERM = true, AFTER_DRAIN = false, HAS_MID = false;
    bf16_t* O; int ldc; const float* SSX; const float* bias; float* SSO; int ssw; int mid_t;
    __device__ __forceinline__ void mid(f32x4 (&)[2][2][4][2], const Unit&, int, int, int, int) const {}
    __device__ __forceinline__ void operator()(const f32x4 (&acc)[2][2][4][2], const Unit& u, int wr, int wc, int fr, int fq) const {
        const int row0 = u.pm * BM + wr * 64 + fr, col0 = u.pn * BM + wc * 32 + 8 * fq;
        f32x4 bv[2][2];
#pragma unroll
        for (int bj = 0; bj < 2; ++bj)
#pragma unroll
            for (int n = 0; n < 2; ++n) bv[bj][n] = BIAS ? *(const f32x4*)(bias + col0 + bj * HALF + 4 * n) : (f32x4){0.f, 0.f, 0.f, 0.f};
#pragma unroll
        for (int ai = 0; ai < 2; ++ai)
#pragma unroll
            for (int m = 0; m < 4; ++m) { const int row = row0 + ai * HALF + m * 16; float s = 1.0f; if (RSCALE) s = rstd_of(sum16(SSX + (size_t)row * 16), 1.0f / 1024.0f);
                float q = 0.f;
#pragma unroll
                for (int bj = 0; bj < 2; ++bj) { const f32x4 v0 = acc[ai][bj][m][0] * s + bv[bj][0], v1 = acc[ai][bj][m][1] * s + bv[bj][1];
                    if (SSQ) q += dot4(v0) + dot4(v1);
                    *(u32x4*)(O + (size_t)row * ldc + col0 + bj * HALF) = pack8(v0, v1); }
                if (SSQ) { q += __shfl_xor(q, 16); q += __shfl_xor(q, 32); if (fq == 0) SSO[(size_t)row * ssw + 4 * u.pn + wc] = q; } }
    }
};

template <bool LSCALE> struct EpiRes {
    static constexpr bool PERM = true, AFTER_DRAIN = false, HAS_MID = LSCALE;
    float* X; bf16_t* XB; float* SSX; const PG8_LAS float* rs_tab; int mid_t;
    __device__ __forceinline__ void mid(f32x4 (&acc)[2][2][4][2], const Unit&, int wr, int, int fr, int) const {
#pragma unroll
        for (int ai = 0; ai < 2; ++ai)
#pragma unroll
            for (int m = 0; m < 4; ++m) { const float f = rs_tab[(ai * HALF + wr * 64 + m * 16 + fr) * 2];
#pragma unroll
                for (int bj = 0; bj < 2; ++bj)
#pragma unroll
                    for (int n = 0; n < 2; ++n) acc[ai][bj][m][n] = acc[ai][bj][m][n] * f; }
    }
    __device__ __forceinline__ void operator()(const f32x4 (&acc)[2][2][4][2], const Unit& u, int wr, int wc, int fr, int fq) const {
        const int row0 = u.pm * BM + wr * 64 + fr, col0 = u.pn * BM + wc * 32 + 8 * fq;
#pragma unroll
        for (int ai = 0; ai < 2; ++ai)
#pragma unroll
            for (int m = 0; m < 4; ++m) { const int row = row0 + ai * HALF + m * 16; float sc = 1.0f; if (LSCALE) sc = rs_tab[(ai * HALF + wr * 64 + m * 16 + fr) * 2 + 1];
                float q = 0.f;
#pragma unroll
                for (int bj = 0; bj < 2; ++bj) { float* xp = X + (size_t)row * 1024 + col0 + bj * HALF;
                    const f32x4 x0 = *(const f32x4*)xp + acc[ai][bj][m][0] * sc, x1 = *(const f32x4*)(xp + 4) + acc[ai][bj][m][1] * sc;
                    *(f32x4*)xp = x0; *(f32x4*)(xp + 4) = x1; q += dot4(x0) + dot4(x1);
                    *(u32x4*)(XB + (size_t)row * 1024 + col0 + bj * HALF) = pack8(x0, x1); }
                q += __shfl_xor(q, 16); q += __shfl_xor(q, 32); if (fq == 0) SSX[(size_t)row * 16 + 4 * u.pn + wc] = q; }
    }
};
struct OneUnit { Unit u; __device__ __forceinline__ bool next(int i, Unit& o) const { if (i != 0) return false; o = u; return true; }
    __device__ __forceinline__ void a_ready(const Unit&) const {} __device__ __forceinline__ void done(const Unit&) const {} };

template <class Epi, class Sched, bool ALIGN_EPI = false, bool SP2 = false>
__device__ __forceinline__ void gemm_phase(PG8_LAS unsigned char* lds, const Gemm g, const Sched& S, const Epi& E) {
    int tid_o = threadIdx.x; asm volatile("" : "+v"(tid_o));
    const int tid = tid_o, wid = __builtin_amdgcn_readfirstlane(tid >> 6), lane = tid & 63, wr = wid >> 2, wc = wid & 3, fr = lane & 15, fq = lane >> 4;
    const int K = g.K, nt = K / BK;
    unsigned voffA[2], voffB[2];
#pragma unroll
    for (int i = 0; i < 2; ++i) { int R, C; stage_rc(tid * 16 + i * 8192, R, C); const int Rb = Epi::PERM ? ((R & ~31) + perm32(R & 31)) : R;
        voffA[i] = (unsigned)(R * K + C) * 2u; voffB[i] = (unsigned)(Rb * K + C) * 2u; }
    const size_t kstep = (size_t)(BK * 2);
    const size_t hstep = (size_t)HALF * K * 2;
    const size_t tstep = 2 * hstep;
    const unsigned ldsw = (unsigned)wid * 1024u;
    const int aoff = lds_byte(wr * 64 + fr, fq * 8), boff = lds_byte(wc * 32 + fr, fq * 8);
#define PG8_SA(b, h) (((b) * 2 + (h)) * HTB)
#define PG8_SB(b, h) ((4 + (b) * 2 + (h)) * HTB)
#define PG8_STAGE(bufoff, gbase, voff) do { _Pragma("unroll") for (int _i = 0; _i < 2; ++_i) \
        __builtin_amdgcn_global_load_lds((const unsigned*)((const char*)(gbase) + (voff)[_i]), (PG8_LAS unsigned*)(lds + (bufoff) + ldsw + _i * 8192), 16, 0, 0); } while (0)
#define PG8_LDA(dst, b, h) do { _Pragma("unroll") for (int m = 0; m < 4; ++m) _Pragma("unroll") for (int k = 0; k < 2; ++k) dst[m][k] = *(const PG8_LAS bf16x8*)(lds + PG8_SA(b, h) + aoff + m * 2048 + k * 1024); } while (0)
#define PG8_LDB(dst, b, h) do { _Pragma("unroll") for (int n = 0; n < 2; ++n) _Pragma("unroll") for (int k = 0; k < 2; ++k) dst[n][k] = *(const PG8_LAS bf16x8*)(lds + PG8_SB(b, h) + boff + n * 2048 + k * 1024); } while (0)
#define PG8_MMA(ai, bj, At, Bt) do { __builtin_amdgcn_s_setprio(1); _Pragma("unroll") for (int m = 0; m < 4; ++m) _Pragma("unroll") for (int n = 0; n < 2; ++n) _Pragma("unroll") for (int k = 0; k < 2; ++k) \
        acc[ai][bj][m][n] = __builtin_amdgcn_mfma_f32_16x16x32_bf16(Bt[n][k], At[m][k], acc[ai][bj][m][n], 0, 0, 0); __builtin_amdgcn_s_setprio(0); } while (0)
#define PG8_WAIT_V(n) asm volatile("s_waitcnt vmcnt(" #n ")" ::: "memory")
#define PG8_WAIT_L(n) asm volatile("s_waitcnt lgkmcnt(" #n ")" ::: "memory")
#define PG8_BAR __builtin_amdgcn_s_barrier()
#define PG8_SCHED __builtin_amdgcn_sched_barrier(0)
    Unit cur, nxt; int ui = 0;
    if (!S.next(0, cur)) return;
    f32x4 acc[2][2][4][2];
#pragma unroll
    for (int a = 0; a < 2; ++a)
#pragma unroll
        for (int b = 0; b < 2; ++b)
#pragma unroll
            for (int m = 0; m < 4; ++m)
#pragma unroll
                for (int n = 0; n < 2; ++n) acc[a][b][m][n] = (f32x4){0.f, 0.f, 0.f, 0.f};
    bf16x8 At[4][2], B0[2][2], B1[2][2];
    const char* cA = (const char*)g.A + (size_t)cur.pm * tstep; const char* cB = (const char*)g.Bt + (size_t)cur.pn * tstep;
    S.a_ready(cur);
    if constexpr (SP2) {
        PG8_STAGE(PG8_SB(0, 0), cB, voffB); PG8_STAGE(PG8_SB(0, 1), cB + hstep, voffB); PG8_STAGE(PG8_SA(0, 0), cA, voffA); PG8_STAGE(PG8_SA(0, 1), cA + hstep, voffA);
        if (wr == 1) PG8_BAR;
        PG8_WAIT_V(2); PG8_BAR;
        PG8_STAGE(PG8_SB(1, 0), cB + kstep, voffB); PG8_STAGE(PG8_SA(1, 0), cA + kstep, voffA); PG8_STAGE(PG8_SB(1, 1), cB + hstep + kstep, voffB);
        PG8_WAIT_V(6); PG8_BAR;
    } else {
        PG8_STAGE(PG8_SB(0, 0), cB, voffB); PG8_STAGE(PG8_SA(0, 0), cA, voffA); PG8_STAGE(PG8_SB(0, 1), cB + hstep, voffB); PG8_STAGE(PG8_SA(0, 1), cA + hstep, voffA);
        if (wr == 1) PG8_BAR;
        PG8_WAIT_V(4); PG8_BAR;
        PG8_STAGE(PG8_SB(1, 0), cB + kstep, voffB); PG8_STAGE(PG8_SA(1, 0), cA + kstep, voffA); PG8_STAGE(PG8_SB(1, 1), cB + hstep + kstep, voffB);
        PG8_WAIT_V(6); PG8_BAR;
    }
    for (;;) {
        const bool has_next = S.next(ui + 1, nxt);
        const char* nA = has_next ? (const char*)g.A + (size_t)nxt.pm * tstep : cA; const char* nB = has_next ? (const char*)g.Bt + (size_t)nxt.pn * tstep : cB;
        for (int t = 0; t < nt; t += 2) {
            const bool last = (t == nt - 2);
            if constexpr (Epi::HAS_MID) { if (t == E.mid_t) E.mid(acc, cur, wr, wc, fr, fq); }
            const char* a1 = cA + (size_t)(t + 1) * kstep;
            const char* a2 = last ? nA : cA + (size_t)(t + 2) * kstep; const char* b2 = last ? nB : cB + (size_t)(t + 2) * kstep;
            const char* a3 = a2 + kstep; const char* b3 = b2 + kstep;
            if (last && has_next) S.a_ready(nxt);
            if constexpr (SP2) {
            PG8_LDB(B0, 0, 0); PG8_LDB(B1, 0, 1); PG8_SCHED; PG8_LDA(At, 0, 0); PG8_STAGE(PG8_SA(1, 1), a1 + hstep, voffA);
            PG8_WAIT_V(8); PG8_WAIT_L(0); PG8_BAR; PG8_MMA(0, 0, At, B0); PG8_MMA(0, 1, At, B1); PG8_BAR; PG8_SCHED;
            PG8_LDA(At, 0, 1); PG8_STAGE(PG8_SB(0, 0), b2, voffB); PG8_STAGE(PG8_SB(0, 1), b2 + hstep, voffB); PG8_STAGE(PG8_SA(0, 0), a2, voffA);
            PG8_WAIT_V(8); PG8_WAIT_L(0); PG8_BAR; PG8_MMA(1, 0, At, B0); PG8_MMA(1, 1, At, B1); PG8_BAR; PG8_SCHED;
            PG8_LDB(B0, 1, 0); PG8_LDB(B1, 1, 1); PG8_SCHED; PG8_LDA(At, 1, 0); PG8_STAGE(PG8_SA(0, 1), a2 + hstep, voffA);
            PG8_WAIT_V(8); PG8_WAIT_L(0); PG8_BAR; PG8_MMA(0, 0, At, B0); PG8_MMA(0, 1, At, B1); PG8_BAR; PG8_SCHED;
            PG8_LDA(At, 1, 1); PG8_STAGE(PG8_SB(1, 0), b3, voffB); PG8_STAGE(PG8_SB(1, 1), b3 + hstep, voffB); PG8_STAGE(PG8_SA(1, 0), a3, voffA);
            PG8_WAIT_V(8); PG8_WAIT_L(0); PG8_BAR; PG8_MMA(1, 0, At, B0); PG8_MMA(1, 1, At, B1); PG8_BAR; PG8_SCHED;
            } else {
            PG8_LDB(B0, 0, 0); PG8_SCHED; PG8_LDA(At, 0, 0); PG8_STAGE(PG8_SA(1, 1), a1 + hstep, voffA);
            PG8_WAIT_L(8); PG8_BAR; PG8_WAIT_L(0); PG8_MMA(0, 0, At, B0); PG8_BAR; PG8_SCHED;
            PG8_LDB(B1, 0, 1); PG8_STAGE(PG8_SB(0, 0), b2, voffB);
            PG8_BAR; PG8_WAIT_L(0); PG8_MMA(0, 1, At, B1); PG8_BAR;
            PG8_LDA(At, 0, 1); PG8_STAGE(PG8_SA(0, 0), a2, voffA);
            PG8_BAR; PG8_WAIT_L(0); PG8_MMA(1, 0, At, B0); PG8_BAR; PG8_SCHED;
            PG8_STAGE(PG8_SB(0, 1), b2 + hstep, voffB);
            PG8_WAIT_V(6); PG8_BAR; PG8_MMA(1, 1, At, B1); PG8_BAR;
            PG8_LDB(B0, 1, 0); PG8_SCHED; PG8_LDA(At, 1, 0); PG8_STAGE(PG8_SA(0, 1), a2 + hstep, voffA);
            PG8_WAIT_L(8); PG8_BAR; PG8_WAIT_L(0); PG8_MMA(0, 0, At, B0); PG8_BAR; PG8_SCHED;
            PG8_LDB(B1, 1, 1); PG8_STAGE(PG8_SB(1, 0), b3, voffB);
            PG8_BAR; PG8_WAIT_L(0); PG8_MMA(0, 1, At, B1); PG8_BAR;
            PG8_LDA(At, 1, 1); PG8_STAGE(PG8_SA(1, 0), a3, voffA);
            PG8_BAR; PG8_WAIT_L(0); PG8_MMA(1, 0, At, B0); PG8_BAR; PG8_SCHED;
            PG8_STAGE(PG8_SB(1, 1), b3 + hstep, voffB);
            PG8_WAIT_V(6); PG8_BAR; PG8_MMA(1, 1, At, B1); PG8_BAR;
            }
        }
        if constexpr (ALIGN_EPI) { if (wr == 0) PG8_BAR; }
        if constexpr (!Epi::AFTER_DRAIN) { E(acc, cur, wr, wc, fr, fq); S.done(cur); }
        if (!has_next) break;
#pragma unroll
        for (int a = 0; a < 2; ++a)
#pragma unroll
            for (int b = 0; b < 2; ++b)
#pragma unroll
                for (int m = 0; m < 4; ++m)
#pragma unroll
                    for (int n = 0; n < 2; ++n) acc[a][b][m][n] = (f32x4){0.f, 0.f, 0.f, 0.f};
        cur = nxt; cA = nA; cB = nB; ++ui;
        if constexpr (ALIGN_EPI) { if (wr == 1) PG8_BAR; }
    }
    PG8_WAIT_V(0);
    if constexpr (!ALIGN_EPI) { if (wr == 0) PG8_BAR; }
    PG8_BAR;
    if constexpr (Epi::AFTER_DRAIN) { E.fused(acc, cur, wr, wc, fr, fq, lds, wid, lane); S.done(cur); }
#undef PG8_SA
#undef PG8_SB
#undef PG8_STAGE
#undef PG8_LDA
#undef PG8_LDB
#undef PG8_MMA
#undef PG8_WAIT_V
#undef PG8_WAIT_L
#undef PG8_BAR
#undef PG8_SCHED
}
}

namespace att {
using bf16x8 = __attribute__((ext_vector_type(8))) short;
using s16x4 = __attribute__((ext_vector_type(4))) short;
using f32x16 = __attribute__((ext_vector_type(16))) float;
using u32x4 = __attribute__((ext_vector_type(4))) unsigned;
typedef unsigned short bf16_t;
#define SBAR() __builtin_amdgcn_sched_barrier(0)
__device__ __forceinline__ int crow(int r, int hi) { return (r & 3) + 8 * (r >> 2) + 4 * hi; }
constexpr int TILEB = 16384, NTILE = 6, LDS_WS = NTILE * TILEB, LDS_OST = LDS_WS + 8 * 64 * 4, LDS_BYTES = LDS_OST + 8 * 4096;
constexpr float LOG2E = 1.4426950408889634f, C2 = 0.125f * LOG2E;
__device__ __forceinline__ void glds16(const void* gsrc, unsigned lds_dst) { unsigned keep;
    asm volatile("s_mov_b32 %0, m0\n\ts_mov_b32 m0, %2\n\ts_nop 0\n\tglobal_load_lds_dwordx4 %1, off\n\ts_mov_b32 m0, %0" : "=&s"(keep) : "v"(gsrc), "s"(lds_dst) : "memory"); }
typedef float f32x2_t __attribute__((ext_vector_type(2))); typedef __bf16 bf16x2_t __attribute__((ext_vector_type(2)));
__device__ __forceinline__ unsigned cvtpk_s(float lo, float hi) { f32x2_t v = {lo, hi}; bf16x2_t b = __builtin_convertvector(v, bf16x2_t); return __builtin_bit_cast(unsigned, b); }
__device__ __forceinline__ void qkt(f32x16& p0, f32x16& p1, const char* Kslot, const bf16x8* qr, const f32x16& negm, int r32, int hi) {
    const char* kb = Kslot + hi * 1024 + r32 * 16;
#pragma unroll
    for (int d0 = 0; d0 < 4; ++d0) {
        const bf16x8 b0 = *reinterpret_cast<const bf16x8*>(kb + d0 * 2048);
        const bf16x8 b1 = *reinterpret_cast<const bf16x8*>(kb + d0 * 2048 + 512);
        if (d0 == 0) { p0 = __builtin_amdgcn_mfma_f32_32x32x16_bf16(b0, qr[0], negm, 0, 0, 0); p1 = __builtin_amdgcn_mfma_f32_32x32x16_bf16(b1, qr[0], negm, 0, 0, 0); }
        else { p0 = __builtin_amdgcn_mfma_f32_32x32x16_bf16(b0, qr[d0], p0, 0, 0, 0); p1 = __builtin_amdgcn_mfma_f32_32x32x16_bf16(b1, qr[d0], p1, 0, 0, 0); } }
}
__device__ __forceinline__ void pv(f32x16* o, int vb, bf16x8 pa0, bf16x8 pa1, bf16x8 pa2, bf16x8 pa3) {
#pragma unroll
    for (int d0 = 0; d0 < 2; ++d0) { s16x4 lo[4], hi[4];
#pragma unroll
        for (int ks = 0; ks < 4; ++ks) {
            asm volatile("ds_read_b64_tr_b16 %0,%1 offset:%c2" : "=&v"(lo[ks]) : "v"(vb), "i"(d0 * 4096 + ks * 1024) : "memory");
            asm volatile("ds_read_b64_tr_b16 %0,%1 offset:%c2" : "=&v"(hi[ks]) : "v"(vb), "i"(d0 * 4096 + ks * 1024 + 512) : "memory"); }
        asm volatile("s_waitcnt lgkmcnt(0)" ::: "memory"); SBAR();
#define PK(k) (bf16x8){lo[k][0], lo[k][1], lo[k][2], lo[k][3], hi[k][0], hi[k][1], hi[k][2], hi[k][3]}
        o[d0] = __builtin_amdgcn_mfma_f32_32x32x16_bf16(pa0, PK(0), o[d0], 0, 0, 0);
        o[d0] = __builtin_amdgcn_mfma_f32_32x32x16_bf16(pa1, PK(1), o[d0], 0, 0, 0);
        o[d0] = __builtin_amdgcn_mfma_f32_32x32x16_bf16(pa2, PK(2), o[d0], 0, 0, 0);
        o[d0] = __builtin_amdgcn_mfma_f32_32x32x16_bf16(pa3, PK(3), o[d0], 0, 0, 0);
#undef PK
    }
}
__device__ __forceinline__ float wmax(float v) {
#pragma unroll
    for (int o = 1; o < 64; o <<= 1) v = fmaxf(v, __shfl_xor(v, o));
    return v;
}
__device__ __forceinline__ void attn_phase(char* shm, const bf16_t* Q, const bf16_t* K, const bf16_t* V, bf16_t* MIX, float* SSA, const float* sink, const float* qg, const float* kg, int vcu, int G) {
    int tid_o = threadIdx.x; asm volatile("" : "+v"(tid_o)); const int tid = tid_o, lane = tid & 63, r32 = lane & 31, hi = lane >> 5; const int wid = __builtin_amdgcn_readfirstlane(tid >> 6);
    const unsigned lds0 = (unsigned)(uintptr_t)shm;
    float* wsf = (float*)(shm + LDS_WS) + wid * 64;
    const float gqm = wmax(fabsf(qg[lane])), gkm = wmax(fabsf(kg[lane]));
    const float B2 = 8.0f * gqm * gkm * LOG2E * 1.02f;
    const int h4 = wid >> 1, e = wid & 1;
    const int vlane = ((lane >> 4) & 1) * 32 + (lane & 3) * 8 + (4 * hi + ((lane & 15) >> 2)) * 64;
    for (int du = vcu; du < 256; du += G) {
        const int b = du >> 6, g = (du >> 5) & 1, j = du & 31;
        const long rowb = (long)b * 4096;
#pragma unroll
        for (int s = 0; s < NTILE; ++s) { const int tt = 2 * j - 2 + s;
            if (tt >= 0 && tt < 64) {
                const bf16_t* ks = K + (rowb + 64 * tt + lane) * 128 + 64 * g + 8 * wid;
                glds16(ks, (unsigned)__builtin_amdgcn_readfirstlane(lds0 + s * TILEB + wid * 1024));
                const bf16_t* vs = V + (rowb + 64 * tt + 16 * (wid & 3) + (lane >> 2)) * 128 + 64 * g + 32 * (wid >> 2) + 8 * (lane & 3);
                glds16(vs, (unsigned)__builtin_amdgcn_readfirstlane(lds0 + s * TILEB + 8192 + wid * 1024)); } }
        asm volatile("s_waitcnt vmcnt(0)\n\ts_barrier" ::: "memory");
        const int h = 4 * g + h4;
        const float sk2 = sink[h] * LOG2E, m2 = fmaxf(B2, sk2);
#pragma unroll 1
        for (int i = 0; i < 2; ++i) {
            const int qb = 2 * j + i, Qs = 64 * qb + 32 * e;
            bf16x8 qr[4];
#pragma unroll
            for (int d0 = 0; d0 < 4; ++d0) qr[d0] = *reinterpret_cast<const bf16x8*>(Q + (rowb + Qs + r32) * 512 + 64 * h + 16 * d0 + 8 * hi);
            f32x16 o[2]; o[0] = f32x16{}; o[1] = f32x16{}; float lsum = 0.f; f32x16 negm;
#pragma unroll
            for (int r = 0; r < 16; ++r) negm[r] = -m2;
            const int qlim = 32 * e + r32;
#pragma unroll
            for (int k = 0; k < 5; ++k) {
                const int tt = qb - 2 + k;
                if (tt >= 0 && tt < 64) {
                    f32x16 p0, p1;
                    qkt(p0, p1, shm + (i + k) * TILEB, qr, negm, r32, hi);
#pragma unroll
                    for (int r = 0; r < 16; ++r) { p0[r] = __builtin_amdgcn_exp2f(p0[r]); p1[r] = __builtin_amdgcn_exp2f(p1[r]); }
                    if (k == 0) {
#pragma unroll
                        for (int r = 0; r < 16; ++r) { const int kv = crow(r, hi); if (kv < qlim) p0[r] = 0.f; if (kv + 32 < qlim) p1[r] = 0.f; } }
                    if (k == 4) {
#pragma unroll
                        for (int r = 0; r < 16; ++r) { const int kv = crow(r, hi); if (kv > qlim) p0[r] = 0.f; if (kv + 32 > qlim) p1[r] = 0.f; } }
                    float sacc = 0.f;
#pragma unroll
                    for (int r = 0; r < 16; ++r) sacc += p0[r] + p1[r];
                    lsum += sacc;
                    u32x4 pw0, pw1, pw2, pw3;
                    pw0 = (u32x4){cvtpk_s(p0[0], p0[1]), cvtpk_s(p0[2], p0[3]), cvtpk_s(p0[4], p0[5]), cvtpk_s(p0[6], p0[7])};
                    pw1 = (u32x4){cvtpk_s(p0[8], p0[9]), cvtpk_s(p0[10], p0[11]), cvtpk_s(p0[12], p0[13]), cvtpk_s(p0[14], p0[15])};
                    pw2 = (u32x4){cvtpk_s(p1[0], p1[1]), cvtpk_s(p1[2], p1[3]), cvtpk_s(p1[4], p1[5]), cvtpk_s(p1[6], p1[7])};
                    pw3 = (u32x4){cvtpk_s(p1[8], p1[9]), cvtpk_s(p1[10], p1[11]), cvtpk_s(p1[12], p1[13]), cvtpk_s(p1[14], p1[15])};
                    SBAR();
                    pv(o, (int)(lds0 + (i + k) * TILEB + 8192) + vlane, __builtin_bit_cast(bf16x8, pw0), __builtin_bit_cast(bf16x8, pw1), __builtin_bit_cast(bf16x8, pw2), __builtin_bit_cast(bf16x8, pw3));
                }
            }
            { auto rr = __builtin_amdgcn_permlane32_swap(__float_as_uint(lsum), __float_as_uint(lsum), false, false); lsum = __uint_as_float(rr[0]) + __uint_as_float(rr[1]); }
            lsum += __builtin_amdgcn_exp2f(sk2 - m2);
            if (hi == 0) wsf[32 + r32] = lsum; asm volatile("s_waitcnt lgkmcnt(0)" ::: "memory");
            float rli[16];
#pragma unroll
            for (int r = 0; r < 16; ++r) rli[r] = __builtin_amdgcn_rcpf(wsf[32 + crow(r, hi)]);
            bf16_t* stg = (bf16_t*)(shm + LDS_OST) + wid * 2048;
#pragma unroll
            for (int r = 0; r < 16; ++r) { const int orow = crow(r, hi);
#pragma unroll
                for (int d0 = 0; d0 < 2; ++d0) stg[orow * 64 + d0 * 32 + r32] = (bf16_t)(cvtpk_s(o[d0][r] * rli[r], 0.f) & 0xffffu); }
            asm volatile("s_waitcnt lgkmcnt(0)" ::: "memory");
#pragma unroll
            for (int i4 = 0; i4 < 4; ++i4) { const int row = i4 * 8 + (lane >> 3), ch = lane & 7; const u32x4 v = *(const u32x4*)(stg + row * 64 + ch * 8);
                *(u32x4*)(MIX + (rowb + Qs + row) * 1024 + 512 + 64 * h + ch * 8) = v;
                float q = 0.f;
#pragma unroll
                for (int t = 0; t < 4; ++t) { const float a = __uint_as_float(v[t] << 16), c = __uint_as_float(v[t] & 0xffff0000u); q += a * a + c * c; }
                q += __shfl_xor(q, 1); q += __shfl_xor(q, 2); q += __shfl_xor(q, 4);
                if (ch == 0) SSA[(rowb + Qs + row) * 8 + h] = q; }
            asm volatile("s_waitcnt lgkmcnt(0)" ::: "memory");
        }
        asm volatile("s_waitcnt lgkmcnt(0)\n\ts_barrier" ::: "memory");
    }
}

template <int STAGE>
__device__ __forceinline__ void dft_phase(char* shm, const bf16_t* in, void* outp, const bf16_t* DC, const bf16_t* DS, const float* TW, int vcu, int G) {
    int tid_o = threadIdx.x; asm volatile("" : "+v"(tid_o)); const int tid = tid_o, lane = tid & 63, r32 = lane & 31, hi = lane >> 5; const int wid = __builtin_amdgcn_readfirstlane(tid >> 6);
    const unsigned lds0 = (unsigned)(uintptr_t)shm;
    char* wbuf = shm + wid * 8192;
    const int vb = (int)(lds0 + wid * 8192) + (8 * hi + ((lane & 15) >> 2)) * 64 + ((lane >> 4) & 1) * 32 + (lane & 3) * 8;
    bf16x8 fc[2][4], fs[2][4];
#pragma unroll
    for (int mb = 0; mb < 2; ++mb)
#pragma unroll
        for (int ks = 0; ks < 4; ++ks) { fc[mb][ks] = *reinterpret_cast<const bf16x8*>(DC + (32 * mb + r32) * 64 + 16 * ks + 8 * hi); fs[mb][ks] = *reinterpret_cast<const bf16x8*>(DS + (32 * mb + r32) * 64 + 16 * ks + 8 * hi); }
    const int NB = STAGE == 1 ? 4096 : 8192;
    const int gw = vcu * 8 + wid, NW = G * 8;
    const int lrow = lane >> 2, lch = lane & 3;
    for (int nb = gw; nb < NB; nb += NW) {
        u32x4 v[4];
        if (STAGE == 1) { const int b = nb >> 10, s2 = (nb >> 4) & 63, c0 = 32 * (nb & 15);
#pragma unroll
            for (int i = 0; i < 4; ++i) v[i] = *(const u32x4*)(in + ((size_t)(b * 4096 + 64 * (lrow + 16 * i) + s2) * 512 + c0 + 8 * lch)); }
        else { const int bk = nb >> 5, cb = nb & 31;
#pragma unroll
            for (int i = 0; i < 4; ++i) v[i] = *(const u32x4*)(in + ((size_t)(bk * 64 + lrow + 16 * i) * 1024 + 32 * cb + 8 * lch)); }
#pragma unroll
        for (int i = 0; i < 4; ++i) *(u32x4*)(wbuf + (lrow + 16 * i) * 64 + lch * 16) = v[i];
        asm volatile("s_waitcnt lgkmcnt(0)" ::: "memory");
        s16x4 lo[4], hh[4];
#pragma unroll
        for (int ks = 0; ks < 4; ++ks) {
            asm volatile("ds_read_b64_tr_b16 %0,%1 offset:%c2" : "=&v"(lo[ks]) : "v"(vb), "i"(ks * 1024) : "memory");
            asm volatile("ds_read_b64_tr_b16 %0,%1 offset:%c2" : "=&v"(hh[ks]) : "v"(vb), "i"(ks * 1024 + 256) : "memory"); }
        asm volatile("s_waitcnt lgkmcnt(0)" ::: "memory"); SBAR();
        f32x16 ac[2], as[2]; ac[0] = f32x16{}; ac[1] = f32x16{}; as[0] = f32x16{}; as[1] = f32x16{};
#pragma unroll
        for (int ks = 0; ks < 4; ++ks) { const bf16x8 bfr = (bf16x8){lo[ks][0], lo[ks][1], lo[ks][2], lo[ks][3], hh[ks][0], hh[ks][1], hh[ks][2], hh[ks][3]};
#pragma unroll
            for (int mb = 0; mb < 2; ++mb) { ac[mb] = __builtin_amdgcn_mfma_f32_32x32x16_bf16(fc[mb][ks], bfr, ac[mb], 0, 0, 0); as[mb] = __builtin_amdgcn_mfma_f32_32x32x16_bf16(fs[mb][ks], bfr, as[mb], 0, 0, 0); } }
        if (STAGE == 1) { const int b = nb >> 10, s2 = (nb >> 4) & 63, c0 = 32 * (nb & 15); unsigned* out = (unsigned*)outp;
#pragma unroll
            for (int mb = 0; mb < 2; ++mb)
#pragma unroll
                for (int rg = 0; rg < 4; ++rg) { const int k1b = 32 * mb + 8 * rg + 4 * hi;
                    const float4 t0 = *(const float4*)(TW + (size_t)(s2 * 64 + k1b) * 2), t1 = *(const float4*)(TW + (size_t)(s2 * 64 + k1b) * 2 + 4);
                    const float cs[4] = {t0.x, t0.z, t1.x, t1.z}, sn[4] = {t0.y, t0.w, t1.y, t1.w};
#pragma unroll
                    for (int rr = 0; rr < 4; ++rr) { const float yc = ac[mb][4 * rg + rr], ys = as[mb][4 * rg + rr];
                        const float zr = yc * cs[rr] - ys * sn[rr], zi = -(yc * sn[rr] + ys * cs[rr]);
                        out[((size_t)((b * 64 + k1b + rr) * 64 + s2)) * 512 + c0 + r32] = cvtpk_s(zr, zi); } }
        } else { const int bk = nb >> 5, cb = nb & 31, b = bk >> 6, k1 = bk & 63; bf16_t* out = (bf16_t*)outp;
#pragma unroll
            for (int mb = 0; mb < 2; ++mb)
#pragma unroll
                for (int r = 0; r < 16; ++r) { const int k2 = 32 * mb + crow(r, hi);
                    const float t = __shfl_xor(as[mb][r], 1); const float x = ac[mb][r] + ((lane & 1) ? -t : t);
                    out[(size_t)(b * 4096 + 64 * k2 + k1) * 1024 + 32 * cb + r32] = (bf16_t)(cvtpk_s(x, 0.f) & 0xffffu); } }
        asm volatile("s_waitcnt lgkmcnt(0)" ::: "memory");
    }
}
#undef SBAR
}

#ifndef PG8_SP2
#define PG8_SP2 true
#endif
#ifndef PG8_ALIGN
#define PG8_ALIGN true
#endif
constexpr int NWAVES = 8;
constexpr int BATCH = 4, SEQ = 4096, D = 1024, M = BATCH * SEQ, DEPTH = 2;
constexpr int FW = 512, NH = 8, HD = 64, INC = 1280, DFF = 2816, UPC = 5632, HALFFF = 1408;
constexpr size_t MiB = 1u << 20;
constexpr size_t WS_CTL = 0, CTL_ZERO_BYTES = 1 * MiB;
constexpr size_t WS_ROPEC = 1 * MiB, WS_ROPES = WS_ROPEC + 512 * 1024, WS_TW = 2 * MiB, WS_DC = WS_TW + 64 * 1024, WS_DS = WS_DC + 16 * 1024;
constexpr size_t WS_GCT = 3 * MiB;
constexpr size_t WS_WIN = 4 * MiB;
constexpr size_t WS_WF = 9 * MiB;
constexpr size_t WS_WO = 10 * MiB;
constexpr size_t WS_WUP = 14 * MiB;
constexpr size_t WS_WDN = 36 * MiB;
constexpr size_t WS_SSX = 47 * MiB;
constexpr size_t WS_XB = 48 * MiB;
constexpr size_t WS_ACT = 80 * MiB;
constexpr size_t WS_UPH = 168 * MiB;
constexpr size_t WS_U = 80 * MiB, WS_Q = 96 * MiB, WS_K = 112 * MiB, WS_V = 116 * MiB, WS_Z = 120 * MiB, WS_W = 152 * MiB, WS_F = 184 * MiB, WS_MIX = 200 * MiB, WS_SSF = 232 * MiB, WS_SSA = WS_SSF + 512 * 1024;
constexpr size_t WS_END = 256 * MiB;
static_assert(WS_UPH + (size_t)M * DFF * 2 == WS_END && WS_ACT + (size_t)M * DFF * 2 == WS_UPH && WS_XB + (size_t)M * D * 2 == WS_ACT, "d_ws map");
constexpr int CW_TMO = 0, CW_CODE = 1;
constexpr int CW_BAR = 4096;
constexpr int RING_OFF = 0, RING_BYTES = 131072;
constexpr int RS_OFF = 133120;
constexpr int LDSCTL_OFF = 139264, MISC_OFF = LDSCTL_OFF + 320;
constexpr int LDS_BYTES = 147456;
static_assert(att::LDS_BYTES <= RS_OFF && RS_OFF + 2048 <= LDSCTL_OFF && MISC_OFF + 128 <= LDS_BYTES, "LDS map");

#define GAS __attribute__((address_space(1)))
#define LAS __attribute__((address_space(3)))
typedef unsigned short bf16;
typedef unsigned v4u __attribute__((ext_vector_type(4)));
typedef float f32x4 __attribute__((ext_vector_type(4)));
typedef GAS unsigned gu32;
#define RLX_AGENT __ATOMIC_RELAXED, __HIP_MEMORY_SCOPE_AGENT
#define LDS_WAIT() asm volatile("s_waitcnt lgkmcnt(0)" ::: "memory")
#define VM_WAIT() asm volatile("s_waitcnt vmcnt(0)" ::: "memory")
__device__ __forceinline__ unsigned f2bf(float f) { unsigned u = __builtin_bit_cast(unsigned, f); return (u + 0x7fffu + ((u >> 16) & 1u)) >> 16; }
__device__ __forceinline__ unsigned pk2(float lo, float hi) { return f2bf(lo) | (f2bf(hi) << 16); }
__device__ __forceinline__ float bflo(unsigned w) { return __uint_as_float(w << 16); }
__device__ __forceinline__ float bfhi(unsigned w) { return __uint_as_float(w & 0xffff0000u); }
#define XB_TMO      128
#define XB_XCNT(j)  (256  + 64 * (j))
#define XB_XSUB(j)  (1280 + 64 * (j))
#define XB_XGEN(j)  (2304 + 64 * (j))
#define XB_TOP      3328
#define XB_TOPGEN   3392
#define XCD_BAR_WORDS 3456
#define XB_SPIN_CAP (1u << 18)

__device__ __forceinline__ unsigned xb_ld(unsigned* p)              { return __hip_atomic_load(p, __ATOMIC_RELAXED, __HIP_MEMORY_SCOPE_AGENT); }
__device__ __forceinline__ unsigned xb_add(unsigned* p, unsigned v) { return __hip_atomic_fetch_add(p, v, __ATOMIC_RELAXED, __HIP_MEMORY_SCOPE_AGENT); }
__device__ __forceinline__ unsigned xb_xcc_id() { return (unsigned)__builtin_amdgcn_s_getreg((3 << 11) | 20) & 0xFu; }
#define XB_SPIN(cond, bar) do { unsigned _sp = 0; while (cond) { __builtin_amdgcn_s_sleep(1); \
    if ((++_sp & 255u) == 0u) { if (xb_ld(&(bar)[XB_TMO])) break; if (_sp > XB_SPIN_CAP) { atomicAdd(&(bar)[XB_TMO], 1u); break; } } } } while (0)

struct XcdBarrier {
    unsigned* bar; unsigned x;
    volatile LAS unsigned* st;
};

__device__ __forceinline__ XcdBarrier xcd_barrier_post(unsigned* bar, volatile LAS unsigned* st) {
    XcdBarrier b; b.bar = bar; b.x = xb_xcc_id(); b.st = st;
    if (threadIdx.x == 0) (void)xb_add(&bar[XB_XCNT(b.x)], 1u);
    return b;
}
__device__ __forceinline__ void xcd_barrier_complete(unsigned* bar, unsigned x, unsigned& nloc, unsigned& nx) {
    const unsigned G = gridDim.x * gridDim.y * gridDim.z;
    unsigned sum, cnt, mine, sp = 0u;
    for (;;) {
        sum = 0u; cnt = 0u; mine = 0u;
#pragma unroll
        for (unsigned j = 0; j < 16; ++j) { const unsigned c = xb_ld(&bar[XB_XCNT(j)]); sum += c; cnt += (c > 0u) ? 1u : 0u; mine = (j == x) ? c : mine; }
        if (sum == G) break;
        __builtin_amdgcn_s_sleep(1);
        if ((++sp & 255u) == 0u) { if (xb_ld(&bar[XB_TMO])) break; if (sp > XB_SPIN_CAP) { atomicAdd(&bar[XB_TMO], 1u); break; } }
    }
    nloc = mine > 0u ? mine : 1u; nx = cnt > 0u ? cnt : 1u;
}

__device__ __forceinline__ void xcd_barrier(const XcdBarrier& b) {
    asm volatile("s_waitcnt vmcnt(0)" ::: "memory");
    __syncthreads();
    if (threadIdx.x == 0) {
        unsigned* bar = b.bar;
        __builtin_amdgcn_s_waitcnt(0);
        unsigned nloc = b.st[0], nx = b.st[1];
        if (nloc == 0u) { xcd_barrier_complete(bar, b.x, nloc, nx); b.st[0] = nloc; b.st[1] = nx; }
        const unsigned old = xb_add(&bar[XB_XSUB(b.x)], 1u);
        const unsigned gen = old / nloc;
        if (old + 1u == (gen + 1u) * nloc) {
            __builtin_amdgcn_fence(__ATOMIC_RELEASE, "agent");
            asm volatile("s_waitcnt vmcnt(0)" ::: "memory");
            const unsigned og = xb_add(&bar[XB_TOP], 1u);
            const unsigned tg = og / nx;
            if (og + 1u == (tg + 1u) * nx) xb_add(&bar[XB_TOPGEN], 1u);
            else XB_SPIN(xb_ld(&bar[XB_TOPGEN]) == tg, bar);
            __builtin_amdgcn_fence(__ATOMIC_ACQUIRE, "agent");
            xb_add(&bar[XB_XGEN(b.x)], 1u);
            asm volatile("s_waitcnt vmcnt(0)" ::: "memory");
        } else {
            XB_SPIN(xb_ld(&bar[XB_XGEN(b.x)]) == gen, bar);
            __builtin_amdgcn_fence(__ATOMIC_ACQUIRE, "agent");
            asm volatile("s_waitcnt vmcnt(0)" ::: "memory");
        }
    }
    __syncthreads();
}

struct Args { const float* in[16]; float* out; unsigned char* ws; int ph_lo, ph_hi, li, pad; };

__device__ __forceinline__ float wave_sum(float v) {
#pragma unroll
    for (int o = 1; o < 64; o <<= 1) v += __shfl_xor(v, o);
    return v;
}
__device__ __forceinline__ void tr_item(const float* W, int K, int N, const float* gain, bf16* WT, int out_row0, LAS float* scr, int k0, int n0, int lane) {
#pragma unroll 8
    for (int i = 0; i < 32; ++i) { const int kk = 2 * i + (lane >> 5); const float gv = gain ? gain[k0 + kk] : 1.0f; scr[kk * 33 + (lane & 31)] = W[(size_t)(k0 + kk) * N + n0 + (lane & 31)] * gv; }
    LDS_WAIT(); asm volatile("" ::: "memory");
    const int c = lane & 7;
#pragma unroll
    for (int j = 0; j < 4; ++j) { const int n = (lane >> 3) + 8 * j; const LAS float* s = scr + (8 * c) * 33 + n;
        v4u o; o.x = pk2(s[0 * 33], s[1 * 33]); o.y = pk2(s[2 * 33], s[3 * 33]); o.z = pk2(s[4 * 33], s[5 * 33]); o.w = pk2(s[6 * 33], s[7 * 33]);
        *(GAS v4u*)(WT + (size_t)(out_row0 + n) * K + k0 + 8 * c) = o; }
    LDS_WAIT(); asm volatile("" ::: "memory");
}
__device__ __forceinline__ int win_pos(int n0) { if (n0 < 512) return n0; const int t = n0 - 512, slot = t >> 6, bj = (t >> 5) & 1; return 256 * (2 + (slot >> 2)) + 128 * bj + 32 * (slot & 3); }
__device__ __forceinline__ int wup_pos(int n0) { if (n0 < DFF) { const int hh = n0 / HALFFF; return hh * DFF + (n0 - hh * HALFFF); } const int t = n0 - DFF, hh = t / HALFFF; return hh * DFF + HALFFF + (t - hh * HALFFF); }

struct PArgs { const float *x, *norm1, *w_in, *w_f, *g_f, *g_a, *w_o, *norm2, *w_up, *w_down; float* out; unsigned char* ws; };
__device__ __forceinline__ void p0_prologue(const PArgs& P, LAS unsigned char* lds, int vcu, int G, int wave, int lane, int tid) {
    LAS float* scr = (LAS float*)(lds + RING_OFF + wave * 16384);
    const int gw = vcu * NWAVES + wave, NGW = G * NWAVES;
    unsigned char* ws = P.ws;
    constexpr int I_IN = (D / 64) * (INC / 32), I_F = (FW / 64) * (FW / 32), I_O = (D / 64) * (D / 32), I_UP = (D / 64) * (UPC / 32), I_DN = (DFF / 64) * (D / 32);
    constexpr int I_LAYER = I_IN + I_F + I_O + I_UP + I_DN;
    for (int it = gw; it < DEPTH * I_LAYER; it += NGW) {
        const int l = it / I_LAYER; int r = it - l * I_LAYER;
        if (r < I_IN) { const int nblk = INC / 32, k0 = 64 * (r / nblk), n0 = 32 * (r % nblk);
            tr_item(P.w_in + (size_t)l * D * INC, D, INC, P.norm1 + l * D, (bf16*)(ws + WS_WIN) + (size_t)l * INC * D, win_pos(n0), scr, k0, n0, lane); continue; } r -= I_IN;
        if (r < I_F) { const int nblk = FW / 32, k0 = 64 * (r / nblk), n0 = 32 * (r % nblk);
            tr_item(P.w_f + (size_t)l * FW * FW, FW, FW, nullptr, (bf16*)(ws + WS_WF) + (size_t)l * FW * FW, n0, scr, k0, n0, lane); continue; } r -= I_F;
        if (r < I_O) { const int nblk = D / 32, k0 = 64 * (r / nblk), n0 = 32 * (r % nblk);
            const float* gain = (k0 < FW) ? (P.g_f + l * FW) : (P.g_a + l * FW - FW);
            tr_item(P.w_o + (size_t)l * D * D, D, D, gain, (bf16*)(ws + WS_WO) + (size_t)l * D * D, n0, scr, k0, n0, lane); continue; } r -= I_O;
        if (r < I_UP) { const int nblk = UPC / 32, k0 = 64 * (r / nblk), n0 = 32 * (r % nblk);
            tr_item(P.w_up + (size_t)l * D * UPC, D, UPC, P.norm2 + l * D, (bf16*)(ws + WS_WUP) + (size_t)l * UPC * D, wup_pos(n0), scr, k0, n0, lane); continue; } r -= I_UP;
        { const int nblk = D / 32, k0 = 64 * (r / nblk), n0 = 32 * (r % nblk);
            tr_item(P.w_down + (size_t)l * DFF * D, DFF, D, nullptr, (bf16*)(ws + WS_WDN) + (size_t)l * D * DFF, n0, scr, k0, n0, lane); }
    }
    const int gt = vcu * (NWAVES * 64) + tid, NGT = G * NWAVES * 64;
    { float* rc = (float*)(ws + WS_ROPEC); float* rs = (float*)(ws + WS_ROPES);
      for (int i = gt; i < SEQ * 32; i += NGT) { const int pos = i >> 5, f = i & 31; const float inv_freq = 1.0f / powf(10000.0f, (float)(2 * f) / 64.0f); const float ang = (float)pos * inv_freq;
          float s, c; sincosf(ang, &s, &c); rc[i] = c; rs[i] = s; } }
    { float* tw = (float*)(ws + WS_TW);
      for (int i = gt; i < 64 * 64; i += NGT) { const int s2 = i >> 6, k1 = i & 63; const float a = (float)((k1 * s2) & 4095) * (2.0f / 4096.0f); tw[2 * i] = cospif(a); tw[2 * i + 1] = sinpif(a); } }
    { bf16* dc = (bf16*)(ws + WS_DC); bf16* ds = (bf16*)(ws + WS_DS);
      for (int i = gt; i < 64 * 64; i += NGT) { const int a = i >> 6, b2 = i & 63; const float t = (float)((a * b2) & 63) * (2.0f / 64.0f); dc[i] = (bf16)f2bf(cospif(t) * 0.125f); ds[i] = (bf16)f2bf(sinpif(t) * 0.125f); } }
    { bf16* gct = (bf16*)(ws + WS_GCT);
      const float sc = 0.04419417382415922f;
      for (int i = gt; i < FW * FW; i += NGT) { const int n = i >> 9, c = i & 511; const float t = (float)((c * n) & 511) * (2.0f / 512.0f);
          ((unsigned*)gct)[i] = pk2(cospif(t) * sc, sinpif(t) * sc); } }
    for (int m = gw; m < M; m += NGW) {
        const GAS f32x4* xr = (const GAS f32x4*)(P.x + (size_t)m * D) + lane; GAS f32x4* orow = (GAS f32x4*)(P.out + (size_t)m * D) + lane;
        GAS unsigned long long* o8 = (GAS unsigned long long*)((bf16*)(ws + WS_XB) + (size_t)m * D) + lane;
        float s = 0.f;
#pragma unroll
        for (int j = 0; j < 4; ++j) { const f32x4 v = xr[64 * j]; orow[64 * j] = v; s += (v.x * v.x + v.y * v.y) + (v.z * v.z + v.w * v.w);
            o8[64 * j] = (unsigned long long)pk2(v.x, v.y) | ((unsigned long long)pk2(v.z, v.w) << 32); }
        s += __shfl_xor(s, 1); s += __shfl_xor(s, 2);
        if ((lane & 3) == 0) ((float*)(ws + WS_SSX))[(size_t)m * 16 + (lane >> 2)] = s;
    }
}

__device__ __forceinline__ void act_phase(const bf16* UPH, bf16* ACT, const float* cw  , const float* cb  , int hh, int vcu, int G, int tid) {
    constexpr int NCG = HALFFF / 8;
    constexpr int RCH = 16;
    const int sub = tid / NCG, cg = tid - sub * NCG;
    if (sub >= 2) return;
    const int c0 = 8 * cg, gcol = HALFFF * hh + c0, vcol = DFF + HALFFF * hh + c0;
    float wg[3][8], wv[3][8], bg[8], bv[8];
#pragma unroll
    for (int t = 0; t < 3; ++t)
#pragma unroll
        for (int e = 0; e < 8; ++e) { wg[t][e] = cw[t * UPC + gcol + e]; wv[t][e] = cw[t * UPC + vcol + e]; }
#pragma unroll
    for (int e = 0; e < 8; ++e) { bg[e] = cb[gcol + e]; bv[e] = cb[vcol + e]; }
    for (int ch = 2 * vcu + sub; ch < M / RCH; ch += 2 * G) {
        const int r0 = ch * RCH;
        float pg[8], pvv[8], cg_[8], cv_[8];
        { const bool ok = (r0 & (SEQ - 1)) != 0;
          v4u a = {0u, 0u, 0u, 0u}, b = {0u, 0u, 0u, 0u};
          if (ok) { a = *(const v4u*)(UPH + (size_t)(r0 - 1) * DFF + c0); b = *(const v4u*)(UPH + (size_t)(r0 - 1) * DFF + HALFFF + c0); }
#pragma unroll
          for (int t = 0; t < 4; ++t) { pg[2 * t] = bflo(a[t]); pg[2 * t + 1] = bfhi(a[t]); pvv[2 * t] = bflo(b[t]); pvv[2 * t + 1] = bfhi(b[t]); } }
        { const v4u a = *(const v4u*)(UPH + (size_t)r0 * DFF + c0), b = *(const v4u*)(UPH + (size_t)r0 * DFF + HALFFF + c0);
#pragma unroll
          for (int t = 0; t < 4; ++t) { cg_[2 * t] = bflo(a[t]); cg_[2 * t + 1] = bfhi(a[t]); cv_[2 * t] = bflo(b[t]); cv_[2 * t + 1] = bfhi(b[t]); } }
#pragma unroll 4
        for (int r = r0; r < r0 + RCH; ++r) {
            const bool ok = ((r + 1) & (SEQ - 1)) != 0;
            v4u a = {0u, 0u, 0u, 0u}, b = {0u, 0u, 0u, 0u};
            if (ok) { a = *(const v4u*)(UPH + (size_t)(r + 1) * DFF + c0); b = *(const v4u*)(UPH + (size_t)(r + 1) * DFF + HALFFF + c0); }
            float ng[8], nv[8];
#pragma unroll
            for (int t = 0; t < 4; ++t) { ng[2 * t] = bflo(a[t]); ng[2 * t + 1] = bfhi(a[t]); nv[2 * t] = bflo(b[t]); nv[2 * t + 1] = bfhi(b[t]); }
            float o[8];
#pragma unroll
            for (int e = 0; e < 8; ++e) { const float gt_ = bg[e] + wg[0][e] * pg[e] + wg[1][e] * cg_[e] + wg[2][e] * ng[e]; const float vt = bv[e] + wv[0][e] * pvv[e] + wv[1][e] * cv_[e] + wv[2][e] * nv[e];
                o[e] = gt_ / (1.0f + __expf(-gt_)) * vt; pg[e] = cg_[e]; cg_[e] = ng[e]; pvv[e] = cv_[e]; cv_[e] = nv[e]; }
            v4u w; w.x = pk2(o[0], o[1]); w.y = pk2(o[2], o[3]); w.z = pk2(o[4], o[5]); w.w = pk2(o[6], o[7]);
            *(v4u*)(ACT + (size_t)r * DFF + HALFFF * hh + c0) = w;
        }
    }
}

constexpr int PH_PER_LAYER = 11, N_PHASES = 1 + DEPTH * PH_PER_LAYER;
typedef __attribute__((address_space(4))) const Args CArgs;
#define KARGS(A) CArgs* A = (CArgs*)__builtin_amdgcn_kernarg_segment_ptr(); asm volatile("" : "+s"(A))
#define OPAQUE_TID(t) int t = threadIdx.x; asm volatile("" : "+v"(t))
__global__ void __launch_bounds__(NWAVES * 64, 2) mk_fwd(Args args_unused) {
    extern __shared__ __attribute__((aligned(16))) unsigned char lds[];
    LAS unsigned char* ldsl = (LAS unsigned char*)lds;
    const int G = gridDim.x; int vcu; { const int bx = blockIdx.x; vcu = (G % 8 == 0) ? (bx % 8) * (G / 8) + bx / 8 : bx; }
    XcdBarrier bar; int lo, hi;
    { KARGS(A); OPAQUE_TID(tid);
      for (int u = tid; u < (LDS_BYTES - LDSCTL_OFF) / 4; u += NWAVES * 64) ((LAS unsigned*)(ldsl + LDSCTL_OFF))[u] = 0u;
      __syncthreads();
      bar = xcd_barrier_post((unsigned*)(A->ws + WS_CTL) + CW_BAR + A->li * XCD_BAR_WORDS, (volatile LAS unsigned*)(ldsl + MISC_OFF) + 8);
      lo = A->ph_lo; hi = A->ph_hi; }
#define IN(k) (lo <= (k) && (k) < hi)
#define SEAM(k) do { if (IN((k) + 1)) xcd_barrier(bar); } while (0)

    if (IN(0)) { KARGS(A); OPAQUE_TID(tid); const int lane = tid & 63, wave = __builtin_amdgcn_readfirstlane(tid >> 6);
        PArgs P{A->in[0], A->in[1], A->in[2], A->in[3], A->in[8], A->in[9], A->in[10], A->in[11], A->in[12], A->in[15], A->out, A->ws}; p0_prologue(P, ldsl, vcu, G, wave, lane, tid); SEAM(0); }

#pragma unroll 1
    for (int l = 0; l < DEPTH; ++l) {
        const int pb = 1 + l * PH_PER_LAYER;
        if (IN(pb + 0)) { KARGS(A); unsigned char* ws = A->ws;
            pg8::Gemm g{(const bf16*)(ws + WS_XB), (const bf16*)(ws + WS_WIN) + (size_t)l * INC * D, M, INC, D}; pg8::StaticOrder S; S.init(M, INC, G, (int)blockIdx.x);
            pg8::EpiIn E{(bf16*)(ws + WS_U), (bf16*)(ws + WS_Q), (bf16*)(ws + WS_K), (bf16*)(ws + WS_V), (const float*)(ws + WS_SSX), (const float*)(ws + WS_ROPEC), (const float*)(ws + WS_ROPES), A->in[5] + l * HD, A->in[6] + l * HD, att::C2, -1};
            pg8::gemm_phase<pg8::EpiIn, pg8::StaticOrder, PG8_ALIGN, PG8_SP2>(ldsl + RING_OFF, g, S, E);
            SEAM(pb + 0);
        }
        if (IN(pb + 1)) { KARGS(A); unsigned char* ws = A->ws;
            att::attn_phase((char*)lds, (const bf16*)(ws + WS_Q), (const bf16*)(ws + WS_K), (const bf16*)(ws + WS_V), (bf16*)(ws + WS_MIX), (float*)(ws + WS_SSA), A->in[7] + l * NH, A->in[5] + l * HD, A->in[6] + l * HD, vcu, G);
            att::dft_phase<1>((char*)lds, (const bf16*)(ws + WS_U), (void*)(ws + WS_Z), (const bf16*)(ws + WS_DC), (const bf16*)(ws + WS_DS), (const float*)(ws + WS_TW), vcu, G);
            SEAM(pb + 1);
        }
        if (IN(pb + 2)) { KARGS(A); unsigned char* ws = A->ws;
            att::dft_phase<2>((char*)lds, (const bf16*)(ws + WS_Z), (void*)(ws + WS_W), (const bf16*)(ws + WS_DC), (const bf16*)(ws + WS_DS), (const float*)(ws + WS_TW), vcu, G);
            SEAM(pb + 2);
        }
        if (IN(pb + 3)) { KARGS(A); unsigned char* ws = A->ws;
            pg8::Gemm g{(const bf16*)(ws + WS_W), (const bf16*)(ws + WS_GCT), M, FW, D}; pg8::StaticOrder S; S.init(M, FW, G, (int)blockIdx.x);
            typedef pg8::EpiStd<false, false, false> E_t; E_t E{(bf16*)(ws + WS_F), FW, nullptr, nullptr, nullptr, 0, -1};
            pg8::gemm_phase<E_t, pg8::StaticOrder, PG8_ALIGN, PG8_SP2>(ldsl + RING_OFF, g, S, E);
            SEAM(pb + 3);
        }
        if (IN(pb + 4)) { KARGS(A); unsigned char* ws = A->ws;
            pg8::Gemm g{(const bf16*)(ws + WS_F), (const bf16*)(ws + WS_WF) + (size_t)l * FW * FW, M, FW, FW}; pg8::StaticOrder S; S.init(M, FW, G, (int)blockIdx.x);
            typedef pg8::EpiStd<false, true, true> E_t; E_t E{(bf16*)(ws + WS_MIX), D, nullptr, A->in[4] + l * FW, (float*)(ws + WS_SSF), 8, -1};
            pg8::gemm_phase<E_t, pg8::StaticOrder, PG8_ALIGN, PG8_SP2>(ldsl + RING_OFF, g, S, E);
            SEAM(pb + 4);
        }
        if (IN(pb + 5)) { KARGS(A); unsigned char* ws = A->ws;
            pg8::StaticOrder S; S.init(M, D, G, (int)blockIdx.x);
            LAS float* rs_tab = (LAS float*)(ldsl + RS_OFF);
            pg8::Unit u;
            for (int i = 0; S.next(i, u); ++i) {
                { OPAQUE_TID(tid); const int row = tid >> 1, which = tid & 1; const float* sp = (const float*)(ws + (which ? WS_SSA : WS_SSF)) + (size_t)(u.pm * 256 + row) * 8;
                  const f32x4 a = *(const f32x4*)sp, b = *(const f32x4*)(sp + 4); const float ss = ((a[0] + a[1]) + (a[2] + a[3])) + ((b[0] + b[1]) + (b[2] + b[3]));
                  const float r = 1.0f / sqrtf(ss * (1.0f / 512.0f) + 1e-6f); const float ro = __shfl_xor(r, 1);
                  if (which == 0) rs_tab[row * 2] = r / ro; else rs_tab[row * 2 + 1] = r; }
                LDS_WAIT(); __syncthreads();
                pg8::Gemm g{(const bf16*)(ws + WS_MIX), (const bf16*)(ws + WS_WO) + (size_t)l * D * D, M, D, D}; pg8::OneUnit S1{u};
                typedef pg8::EpiRes<true> E_t; E_t E{A->out, (bf16*)(ws + WS_XB), (float*)(ws + WS_SSX), rs_tab, 8};
                pg8::gemm_phase<E_t, pg8::OneUnit, false, PG8_SP2>(ldsl + RING_OFF, g, S1, E);
                __syncthreads();
            }
            SEAM(pb + 5);
        }
#pragma unroll 1
        for (int hh = 0; hh < 2; ++hh) {
            if (IN(pb + 6 + 2 * hh)) { KARGS(A); unsigned char* ws = A->ws;
                pg8::Gemm g{(const bf16*)(ws + WS_XB), (const bf16*)(ws + WS_WUP) + (size_t)l * UPC * D + (size_t)hh * DFF * D, M, DFF, D}; pg8::StaticOrder S; S.init(M, DFF, G, (int)blockIdx.x);
                typedef pg8::EpiStd<true, false, false> E_t; E_t E{(bf16*)(ws + WS_UPH), DFF, (const float*)(ws + WS_SSX), nullptr, nullptr, 0, -1};
                pg8::gemm_phase<E_t, pg8::StaticOrder, PG8_ALIGN, PG8_SP2>(ldsl + RING_OFF, g, S, E);
                SEAM(pb + 6 + 2 * hh);
            }
            if (IN(pb + 7 + 2 * hh)) { KARGS(A); unsigned char* ws = A->ws; OPAQUE_TID(tid);
                act_phase((const bf16*)(ws + WS_UPH), (bf16*)(ws + WS_ACT), A->in[13] + (size_t)l * 3 * UPC, A->in[14] + (size_t)l * UPC, hh, vcu, G, tid);
                SEAM(pb + 7 + 2 * hh);
            }
        }
        if (IN(pb + 10)) { KARGS(A); unsigned char* ws = A->ws;
            pg8::Gemm g{(const bf16*)(ws + WS_ACT), (const bf16*)(ws + WS_WDN) + (size_t)l * D * DFF, M, D, DFF}; pg8::StaticOrder S; S.init(M, D, G, (int)blockIdx.x);
            typedef pg8::EpiRes<false> E_t; E_t E{A->out, (bf16*)(ws + WS_XB), (float*)(ws + WS_SSX), nullptr, -1};
            pg8::gemm_phase<E_t, pg8::StaticOrder, PG8_ALIGN, PG8_SP2>(ldsl + RING_OFF, g, S, E);
            SEAM(pb + 10);
        }
    }
#undef IN
#undef SEAM
}

extern "C" void kernel_launch(void* const* d_in, const int* in_sizes, int n_in, void* d_out, int out_size, void* d_ws, size_t ws_size, hipStream_t stream) {
    static int grid = 0;
    if (grid == 0) {
        if (n_in != 16 || in_sizes[0] != M * D || out_size != M * D || ws_size < WS_END) { fprintf(stderr, "kernel_launch: unexpected shapes (n_in %d, in0 %d, out %d, ws %zu); nothing launched\n", n_in, n_in > 0 ? in_sizes[0] : -1, out_size, ws_size); grid = -1; return; }
        int dev = 0, cus = 0, per_cu = 0;
        if (hipGetDevice(&dev) != hipSuccess || hipDeviceGetAttribute(&cus, hipDeviceAttributeMultiprocessorCount, dev) != hipSuccess) { grid = -1; return; }
        if (hipFuncSetAttribute((const void*)mk_fwd, hipFuncAttributeMaxDynamicSharedMemorySize, LDS_BYTES) != hipSuccess) { fprintf(stderr, "kernel_launch: hipFuncSetAttribute failed\n"); grid = -1; return; }
        if (hipOccupancyMaxActiveBlocksPerMultiprocessor(&per_cu, (const void*)mk_fwd, NWAVES * 64, LDS_BYTES) != hipSuccess || per_cu < 1) { fprintf(stderr, "kernel_launch: occupancy query says %d blocks per CU; nothing launched\n", per_cu); (void)hipGetLastError(); grid = -1; return; }
        grid = cus;
    }
    if (grid < 0) return;
    (void)hipMemsetAsync((char*)d_ws + WS_CTL, 0, CTL_ZERO_BYTES, stream);
    Args a{};
    for (int i = 0; i < 16; ++i) a.in[i] = (const float*)d_in[i];
    a.out = (float*)d_out; a.ws = (unsigned char*)d_ws;
#ifndef MK_CUTS
    a.ph_lo = 0; a.ph_hi = N_PHASES; a.li = 0;
    hipLaunchKernelGGL(mk_fwd, dim3(grid), dim3(NWAVES * 64), LDS_BYTES, stream, a);
#else
    { const int cuts[] = {MK_CUTS}; const int nc = (int)(sizeof(cuts) / sizeof(int)); int lo = 0;
      for (int li = 0; li <= nc; ++li) { const int hi = li < nc ? cuts[li] : N_PHASES; a.ph_lo = lo; a.ph_hi = hi; a.li = li; hipLaunchKernelGGL(mk_fwd, dim3(grid), dim3(NWAVES * 64), LDS_BYTES, stream, a); lo = hi; } }
#endif
}
```

```cpp
#include <hip/hip_runtime.h>
#include <cstdio>
#include <cstdint>
#include <cmath>
namespace pg8 {
#define PG8_LAS __attribute__((address_space(3)))
typedef unsigned short bf16_t;
typedef short bf16x8 __attribute__((ext_vector_type(8)));
typedef float f32x4 __attribute__((ext_vector_type(4)));
typedef unsigned u32x4 __attribute__((ext_vector_type(4)));
constexpr int BM = 256, BK = 64, HALF = 128, HTB = HALF * BK * 2  , STAGE_BYTES = 8 * HTB, NXCD = 8, WGM = 8;

__host__ __device__ __forceinline__ int lds_byte(int r, int c) { const int st = (r >> 4) * 2 + (c >> 5), rr = r & 15, cc = c & 31, ob = rr * 64 + cc * 2; return st * 1024 + (ob ^ (((ob >> 9) & 1) << 5)); }
__host__ __device__ __forceinline__ void stage_rc(int b, int& R, int& C) { const int st = b / 1024, sb = b % 1024, swz = sb ^ (((sb >> 9) & 1) << 5); R = (st >> 1) * 16 + swz / 64; C = (st & 1) * 32 + (swz % 64) / 2; }
__host__ __device__ __forceinline__ int perm32(int rho) { const int n = rho >> 4, i = rho & 15; return 8 * (i >> 2) + 4 * n + (i & 3); }

struct Unit { int pm, pn; };
struct Gemm { const bf16_t* A; const bf16_t* Bt; int M, N, K; };

struct StaticOrder {
    int nM, nN, nwg, G, c;
    __host__ __device__ void init(int M, int N, int G_, int c_) { nM = M / BM; nN = N / BM; nwg = nM * nN; G = G_; c = c_; }
    __host__ __device__ bool next(int i, Unit& u) const {
        const long L = (long)i * G + c; if (L >= nwg) return false;
        int wgid = (int)L; { const int q = nwg / NXCD, r = nwg % NXCD, xcd = wgid % NXCD, off = wgid / NXCD; wgid = (xcd < r ? xcd * (q + 1) : r * (q + 1) + (xcd - r) * q) + off; }
        const int nig = WGM * nN, gid = wgid / nig, fm = gid * WGM, gsz = (nM - fm) < WGM ? (nM - fm) : WGM;
        u.pm = fm + ((wgid % nig) % gsz); u.pn = (wgid % nig) / gsz; return true;
    }
    __device__ __forceinline__ void a_ready(const Unit&) const {}
    __device__ __forceinline__ void done(const Unit&) const {}
};


typedef float f32x2_t __attribute__((ext_vector_type(2))); typedef __bf16 bf16x2_t __attribute__((ext_vector_type(2)));
__device__ __forceinline__ unsigned cvtpk(float lo, float hi) { f32x2_t v = {lo, hi}; bf16x2_t b = __builtin_convertvector(v, bf16x2_t); return __builtin_bit_cast(unsigned, b); }
__device__ __forceinline__ u32x4 pack8(const f32x4 a, const f32x4 b) { u32x4 w; w.x = cvtpk(a[0], a[1]); w.y = cvtpk(a[2], a[3]); w.z = cvtpk(b[0], b[1]); w.w = cvtpk(b[2], b[3]); return w; }
__device__ __forceinline__ float dot4(const f32x4 a) { return (a[0] * a[0] + a[1] * a[1]) + (a[2] * a[2] + a[3] * a[3]); }
__device__ __forceinline__ float sum16(const float* p) { const f32x4 a = *(const f32x4*)p, b = *(const f32x4*)(p + 4), c = *(const f32x4*)(p + 8), d = *(const f32x4*)(p + 12);
    return (((a[0] + a[1]) + (a[2] + a[3])) + ((b[0] + b[1]) + (b[2] + b[3]))) + (((c[0] + c[1]) + (c[2] + c[3])) + ((d[0] + d[1]) + (d[2] + d[3]))); }
constexpr float RMS_EPS = 1e-6f;
__device__ __forceinline__ float rstd_of(float ss, float inv_n) { return 1.0f / sqrtf(ss * inv_n + RMS_EPS); }

struct EpiIn {
    static constexpr bool PERM = true, AFTER_DRAIN = false, HAS_MID = false;
    bf16_t *U, *Q, *Kb, *Vb; const float* SSX; const float* ropec; const float* ropes; const float* qg; const float* kg; float qscale; int mid_t;
    __device__ __forceinline__ void mid(f32x4 (&)[2][2][4][2], const Unit&, int, int, int, int) const {}
    __device__ __forceinline__ void operator()(const f32x4 (&acc)[2][2][4][2], const Unit& u, int wr, int wc, int fr, int fq) const {
        const int row0 = u.pm * BM + wr * 64 + fr;
        if (u.pn < 2) {
            const int col0 = u.pn * BM + wc * 32 + 8 * fq;
#pragma unroll
            for (int ai = 0; ai < 2; ++ai)
#pragma unroll
                for (int m = 0; m < 4; ++m) { const int row = row0 + ai * HALF + m * 16; const float s = rstd_of(sum16(SSX + (size_t)row * 16), 1.0f / 1024.0f);
#pragma unroll
                    for (int bj = 0; bj < 2; ++bj) *(u32x4*)(U + (size_t)row * 512 + col0 + bj * HALF) = pack8(acc[ai][bj][m][0] * s, acc[ai][bj][m][1] * s); }
        } else {
            const int slot = 4 * (u.pn - 2) + wc;
            if (slot >= 10) {
#pragma unroll
                for (int ai = 0; ai < 2; ++ai)
#pragma unroll
                    for (int m = 0; m < 4; ++m) { const int row = row0 + ai * HALF + m * 16; const float s = rstd_of(sum16(SSX + (size_t)row * 16), 1.0f / 1024.0f);
#pragma unroll
                        for (int bj = 0; bj < 2; ++bj) *(u32x4*)(Vb + (size_t)row * 128 + 64 * (slot - 10) + 32 * bj + 8 * fq) = pack8(acc[ai][bj][m][0] * s, acc[ai][bj][m][1] * s); }
            } else {
                const bool isq = slot < 8; const float* gp = isq ? qg : kg;
                f32x4 g[2][2];
#pragma unroll
                for (int bj = 0; bj < 2; ++bj)
#pragma unroll
                    for (int n = 0; n < 2; ++n) g[bj][n] = *(const f32x4*)(gp + 32 * bj + 8 * fq + 4 * n);
                bf16_t* dst = isq ? (Q + 64 * slot) : (Kb + 64 * (slot - 8)); const int ld = isq ? 512 : 128; const float osc = isq ? qscale : 1.0f;
#pragma unroll
                for (int ai = 0; ai < 2; ++ai)
#pragma unroll
                    for (int m = 0; m < 4; ++m) { const int row = row0 + ai * HALF + m * 16; const float s = rstd_of(sum16(SSX + (size_t)row * 16), 1.0f / 1024.0f);
                        f32x4 y[2][2]; float ss = 0.f;
#pragma unroll
                        for (int bj = 0; bj < 2; ++bj)
#pragma unroll
                            for (int n = 0; n < 2; ++n) { y[bj][n] = acc[ai][bj][m][n] * s; ss += dot4(y[bj][n]); }
                        ss += __shfl_xor(ss, 16); ss += __shfl_xor(ss, 32);
                        const float rn = rstd_of(ss, 1.0f / 64.0f);
                        const int pos = row & 4095;
                        f32x4 o1[2], o2[2];
#pragma unroll
                        for (int n = 0; n < 2; ++n) { const f32x4 c = *(const f32x4*)(ropec + pos * 32 + 8 * fq + 4 * n), sn = *(const f32x4*)(ropes + pos * 32 + 8 * fq + 4 * n);
                            const f32x4 y1 = y[0][n] * rn * g[0][n], y2 = y[1][n] * rn * g[1][n];
                            o1[n] = (y1 * c - y2 * sn) * osc; o2[n] = (y2 * c + y1 * sn) * osc; }
                        *(u32x4*)(dst + (size_t)row * ld + 8 * fq) = pack8(o1[0], o1[1]);
                        *(u32x4*)(dst + (size_t)row * ld + 32 + 8 * fq) = pack8(o2[0], o2[1]); }
            }
        }
    }
};

template <bool RSCALE, bool BIAS, bool SSQ> struct EpiStd {
    static constexpr bool PERM = true, AFTER_DRAIN = false, HAS_MID = false;
    bf16_t* O; int ldc; const float* SSX; const float* bias; float* SSO; int ssw; int mid_t;
    __device__ __forceinline__ void mid(f32x4 (&)[2][2][4][2], const Unit&, int, int, int, int) const {}
    __device__ __forceinline__ void operator()(const f32x4 (&acc)[2][2][4][2], const Unit& u, int wr, int wc, int fr, int fq) const {
        const int row0 = u.pm * BM + wr * 64 + fr, col0 = u.pn * BM + wc * 32 + 8 * fq;
        f32x4 bv[2][2];
#pragma unroll
        for (int bj = 0; bj < 2; ++bj)
#pragma unroll
            for (int n = 0; n < 2; ++n) bv[bj][n] = BIAS ? *(const f32x4*)(bias + col0 + bj * HALF + 4 * n) : (f32x4){0.f, 0.f, 0.f, 0.f};
#pragma unroll
        for (int ai = 0; ai < 2; ++ai)
#pragma unroll
            for (int m = 0; m < 4; ++m) { const int row = row0 + ai * HALF + m * 16; float s = 1.0f; if (RSCALE) s = rstd_of(sum16(SSX + (size_t)row * 16), 1.0f / 1024.0f);
                float q = 0.f;
#pragma unroll
                for (int bj = 0; bj < 2; ++bj) { const f32x4 v0 = acc[ai][bj][m][0] * s + bv[bj][0], v1 = acc[ai][bj][m][1] * s + bv[bj][1];
                    if (SSQ) q += dot4(v0) + dot4(v1);
                    *(u32x4*)(O + (size_t)row * ldc + col0 + bj * HALF) = pack8(v0, v1); }
                if (SSQ) { q += __shfl_xor(q, 16); q += __shfl_xor(q, 32); if (fq == 0) SSO[(size_t)row * ssw + 4 * u.pn + wc] = q; } }
    }
};

template <bool LSCALE> struct EpiRes {
    static constexpr bool PERM = true, AFTER_DRAIN = false, HAS_MID = LSCALE;
    const float* Xin; float* X; bf16_t* XB; float* SSX; const PG8_LAS float* rs_tab; int mid_t;
    __device__ __forceinline__ void mid(f32x4 (&acc)[2][2][4][2], const Unit&, int wr, int, int fr, int) const {
#pragma unroll
        for (int ai = 0; ai < 2; ++ai)
#pragma unroll
            for (int m = 0; m < 4; ++m) { const float f = rs_tab[(ai * HALF + wr * 64 + m * 16 + fr) * 2];
#pragma unroll
                for (int bj = 0; bj < 2; ++bj)
#pragma unroll
                    for (int n = 0; n < 2; ++n) acc[ai][bj][m][n] = acc[ai][bj][m][n] * f; }
    }
    __device__ __forceinline__ void operator()(const f32x4 (&acc)[2][2][4][2], const Unit& u, int wr, int wc, int fr, int fq) const {
        const int row0 = u.pm * BM + wr * 64 + fr, col0 = u.pn * BM + wc * 32 + 8 * fq;
#pragma unroll
        for (int ai = 0; ai < 2; ++ai)
#pragma unroll
            for (int m = 0; m < 4; ++m) { const int row = row0 + ai * HALF + m * 16; float sc = 1.0f; if (LSCALE) sc = rs_tab[(ai * HALF + wr * 64 + m * 16 + fr) * 2 + 1];
                float q = 0.f;
#pragma unroll
                for (int bj = 0; bj < 2; ++bj) { float* xp = X + (size_t)row * 1024 + col0 + bj * HALF; const float* xi = Xin + (size_t)row * 1024 + col0 + bj * HALF;
                    const f32x4 x0 = *(const f32x4*)xi + acc[ai][bj][m][0] * sc, x1 = *(const f32x4*)(xi + 4) + acc[ai][bj][m][1] * sc;
                    *(f32x4*)xp = x0; *(f32x4*)(xp + 4) = x1; q += dot4(x0) + dot4(x1);
                    *(u32x4*)(XB + (size_t)row * 1024 + col0 + bj * HALF) = pack8(x0, x1); }
                q += __shfl_xor(q, 16); q += __shfl_xor(q, 32); if (fq == 0) SSX[(size_t)row * 16 + 4 * u.pn + wc] = q; }
    }
};

__device__ __forceinline__ float dpp_ror1(float x) { return __builtin_bit_cast(float, __builtin_amdgcn_update_dpp(0, __builtin_bit_cast(int, x), 0x121, 0xf, 0xf, false)); }
__device__ __forceinline__ float dpp_ror15(float x) { return __builtin_bit_cast(float, __builtin_amdgcn_update_dpp(0, __builtin_bit_cast(int, x), 0x12F, 0xf, 0xf, false)); }
__device__ __forceinline__ f32x4 ror1_4(const f32x4 v) { return (f32x4){dpp_ror1(v[0]), dpp_ror1(v[1]), dpp_ror1(v[2]), dpp_ror1(v[3])}; }
__device__ __forceinline__ f32x4 ror15_4(const f32x4 v) { return (f32x4){dpp_ror15(v[0]), dpp_ror15(v[1]), dpp_ror15(v[2]), dpp_ror15(v[3])}; }
__device__ __forceinline__ f32x4 sel4(bool c, const f32x4 a, const f32x4 b) { return (f32x4){c ? a[0] : b[0], c ? a[1] : b[1], c ? a[2] : b[2], c ? a[3] : b[3]}; }
struct EpiUpConv {
    static constexpr bool PERM = true, AFTER_DRAIN = false, HAS_MID = false;
    bf16_t* ACT; const float* SSX; const float* cw; const float* cb; float* HALO; PG8_LAS float* HT; int mid_t;
    __device__ __forceinline__ void mid(f32x4 (&)[2][2][4][2], const Unit&, int, int, int, int) const {}
    __device__ __forceinline__ void operator()(f32x4 (&acc)[2][2][4][2], const Unit& u, int wr, int wc, int fr_in, int fq_in) const {
        int fr = fr_in, fq = fq_in; asm volatile("" : "+v"(fr), "+v"(fq));
        const int row0 = u.pm * BM + wr * 64 + fr, tcol = wc * 32 + 8 * fq;
#pragma unroll
        for (int ai = 0; ai < 2; ++ai)
#pragma unroll
            for (int m = 0; m < 4; ++m) { const float s = rstd_of(sum16(SSX + (size_t)(row0 + ai * HALF + m * 16) * 16), 1.0f / 1024.0f);
#pragma unroll
                for (int bj = 0; bj < 2; ++bj)
#pragma unroll
                    for (int n = 0; n < 2; ++n) acc[ai][bj][m][n] = acc[ai][bj][m][n] * s;
                if (m & 1) asm volatile("" ::: "memory"); }
        PG8_LAS float* H2 = HT + 2048;
        { const int lane_ = fq * 16 + fr; PG8_LAS float* dump = HT + 3584 + lane_ * 4;
#pragma unroll
          for (int ai = 0; ai < 2; ++ai) { const int rho = 2 * ai + wr;
              PG8_LAS float* pf = (fr == 0) ? HT + (rho * 2 + 0) * 256 + tcol : dump; PG8_LAS float* pl = (fr == 15) ? HT + (rho * 2 + 1) * 256 + tcol : dump;
#pragma unroll
              for (int bj = 0; bj < 2; ++bj)
#pragma unroll
                  for (int n = 0; n < 2; ++n) { *(PG8_LAS f32x4*)(pf + ((fr == 0) ? 128 * bj + 4 * n : 0)) = acc[ai][bj][0][n]; *(PG8_LAS f32x4*)(pl + ((fr == 15) ? 128 * bj + 4 * n : 0)) = acc[ai][bj][3][n]; } }
          const bool s1 = (wr == 0) && (fr == 1), s254 = (wr == 1) && (fr == 14);
          PG8_LAS float* p1 = s1 ? H2 + tcol : dump; PG8_LAS float* p254 = s254 ? H2 + 256 + tcol : dump;
#pragma unroll
          for (int bj = 0; bj < 2; ++bj)
#pragma unroll
              for (int n = 0; n < 2; ++n) { *(PG8_LAS f32x4*)(p1 + (s1 ? 128 * bj + 4 * n : 0)) = acc[0][bj][0][n]; *(PG8_LAS f32x4*)(p254 + (s254 ? 128 * bj + 4 * n : 0)) = acc[1][bj][3][n]; } }
        PG8_LAS float* LW = HT + 2560;
        { const int tid = (wr * 4 + wc) * 64 + fq * 16 + fr;
#pragma unroll
          for (int k = 0; k < 2; ++k) { const int idx = tid + 512 * k, r = idx >> 8, t = idx & 255, col = (t >> 7) * 2816 + u.pn * 128 + (t & 127); LW[idx] = r < 3 ? cw[r * 5632 + col] : cb[col]; } }
        asm volatile("s_waitcnt lgkmcnt(0)" ::: "memory"); __builtin_amdgcn_s_barrier(); asm volatile("" ::: "memory");
        const auto act_rsrc = __builtin_amdgcn_make_buffer_rsrc(ACT, 0, 16384 * 2816 * 2, 0x00020000);
        const unsigned act_voff = (unsigned)((row0 * 2816 + u.pn * 128 + tcol) * 2);
        const bool e0 = fr == 0, e15 = fr == 15;
#pragma unroll
        for (int ai = 0; ai < 2; ++ai) { const int rho = 2 * ai + wr;
            unsigned pk0[4][2];
#pragma unroll
            for (int n = 0; n < 2; ++n) {
                f32x4 cv0[4];
#pragma unroll
                for (int bj = 0; bj < 2; ++bj) { const PG8_LAS float* lw = LW + 128 * bj + tcol + 4 * n;
                    const f32x4 w0 = *(const PG8_LAS f32x4*)lw, w1 = *(const PG8_LAS f32x4*)(lw + 256), w2 = *(const PG8_LAS f32x4*)(lw + 512), bb = *(const PG8_LAS f32x4*)(lw + 768);
                    const int rp = rho > 0 ? rho - 1 : 0, rn_ = rho < 3 ? rho + 1 : 3;
                    const f32x4 hp = *(const PG8_LAS f32x4*)(HT + (rp * 2 + 1) * 256 + 128 * bj + tcol + 4 * n), hn = *(const PG8_LAS f32x4*)(HT + (rn_ * 2 + 0) * 256 + 128 * bj + tcol + 4 * n);
                    f32x4 redge = hp, lcur = ror15_4(acc[ai][bj][0][n]);
#pragma unroll
                    for (int m = 0; m < 4; ++m) { const f32x4 x = acc[ai][bj][m][n];
                        const f32x4 r = ror1_4(x); const f32x4 lnext = (m < 3) ? ror15_4(acc[ai][bj][m < 3 ? m + 1 : 3][n]) : hn;
                        const f32x4 pv_ = sel4(e0, redge, r), nx = sel4(e15, lnext, lcur);
                        const f32x4 c = bb + w0 * pv_ + w1 * x + w2 * nx;
                        redge = r; lcur = lnext; __builtin_amdgcn_sched_barrier(0);
                        if (bj == 0) cv0[m] = c;
                        else { f32x4 o;
#pragma unroll
                            for (int e = 0; e < 4; ++e) { const float g = cv0[m][e]; o[e] = g * __builtin_amdgcn_rcpf(1.0f + __builtin_amdgcn_exp2f(-1.4426950408889634f * g)) * c[e]; }
                            const unsigned p0 = cvtpk(o[0], o[1]), p1 = cvtpk(o[2], o[3]);
                            if (n == 0) { pk0[m][0] = p0; pk0[m][1] = p1; }
                            else { u32x4 w; w.x = pk0[m][0]; w.y = pk0[m][1]; w.z = p0; w.w = p1;
                                __builtin_amdgcn_raw_buffer_store_b128(w, act_rsrc, act_voff, (ai * HALF + m * 16) * 2816 * 2, 0); } } }
                }
                asm volatile("" ::: "memory"); __builtin_amdgcn_sched_barrier(0);
            }
        }
        { const int tid = (wr * 4 + wc) * 64 + fq * 16 + fr;
#pragma unroll
          for (int k = 0; k < 2; ++k) { const int idx = tid + 512 * k, r = idx >> 8, t = idx & 255;
              const PG8_LAS float* src = (r == 0) ? HT + t : (r == 1) ? H2 + t : (r == 2) ? H2 + 256 + t : HT + (3 * 2 + 1) * 256 + t;
              HALO[(size_t)(u.pm * 4 + r) * 5632 + u.pn * 256 + t] = *src; } }
    }
};
struct OneUnit { Unit u; __device__ __forceinline__ bool next(int i, Unit& o) const { if (i != 0) return false; o = u; return true; }
    __device__ __forceinline__ void a_ready(const Unit&) const {} __device__ __forceinline__ void done(const Unit&) const {} };

template <class Epi, class Sched, bool ALIGN_EPI = false, bool SP2 = false>
__device__ __forceinline__ void gemm_phase(PG8_LAS unsigned char* lds, const Gemm g, const Sched& S, const Epi& E) {
    int tid_o = threadIdx.x; asm volatile("" : "+v"(tid_o));
    const int tid = tid_o, wid = __builtin_amdgcn_readfirstlane(tid >> 6), lane = tid & 63, wr = wid >> 2, wc = wid & 3, fr = lane & 15, fq = lane >> 4;
    const int K = g.K, nt = K / BK;
    unsigned voffA[2], voffB[2];
#pragma unroll
    for (int i = 0; i < 2; ++i) { int R, C; stage_rc(tid * 16 + i * 8192, R, C); const int Rb = Epi::PERM ? ((R & ~31) + perm32(R & 31)) : R;
        voffA[i] = (unsigned)(R * K + C) * 2u; voffB[i] = (unsigned)(Rb * K + C) * 2u; }
    const size_t kstep = (size_t)(BK * 2);
    const size_t hstep = (size_t)HALF * K * 2;
    const size_t tstep = 2 * hstep;
    const unsigned ldsw = (unsigned)wid * 1024u;
    const int aoff = lds_byte(wr * 64 + fr, fq * 8), boff = lds_byte(wc * 32 + fr, fq * 8);
#define PG8_SA(b, h) (((b) * 2 + (h)) * HTB)
#define PG8_SB(b, h) ((4 + (b) * 2 + (h)) * HTB)
#define PG8_STAGE(bufoff, gbase, voff) do { _Pragma("unroll") for (int _i = 0; _i < 2; ++_i) \
        __builtin_amdgcn_global_load_lds((const unsigned*)((const char*)(gbase) + (voff)[_i]), (PG8_LAS unsigned*)(lds + (bufoff) + ldsw + _i * 8192), 16, 0, 0); } while (0)
#define PG8_LDA(dst, b, h) do { _Pragma("unroll") for (int m = 0; m < 4; ++m) _Pragma("unroll") for (int k = 0; k < 2; ++k) dst[m][k] = *(const PG8_LAS bf16x8*)(lds + PG8_SA(b, h) + aoff + m * 2048 + k * 1024); } while (0)
#define PG8_LDB(dst, b, h) do { _Pragma("unroll") for (int n = 0; n < 2; ++n) _Pragma("unroll") for (int k = 0; k < 2; ++k) dst[n][k] = *(const PG8_LAS bf16x8*)(lds + PG8_SB(b, h) + boff + n * 2048 + k * 1024); } while (0)
#define PG8_MMA(ai, bj, At, Bt) do { __builtin_amdgcn_s_setprio(1); _Pragma("unroll") for (int m = 0; m < 4; ++m) _Pragma("unroll") for (int n = 0; n < 2; ++n) _Pragma("unroll") for (int k = 0; k < 2; ++k) \
        acc[ai][bj][m][n] = __builtin_amdgcn_mfma_f32_16x16x32_bf16(Bt[n][k], At[m][k], acc[ai][bj][m][n], 0, 0, 0); __builtin_amdgcn_s_setprio(0); } while (0)
#define PG8_WAIT_V(n) asm volatile("s_waitcnt vmcnt(" #n ")" ::: "memory")
#define PG8_WAIT_L(n) asm volatile("s_waitcnt lgkmcnt(" #n ")" ::: "memory")
#define PG8_BAR __builtin_amdgcn_s_barrier()
#define PG8_SCHED __builtin_amdgcn_sched_barrier(0)
    Unit cur, nxt; int ui = 0;
    if (!S.next(0, cur)) return;
    f32x4 acc[2][2][4][2];
#pragma unroll
    for (int a = 0; a < 2; ++a)
#pragma unroll
        for (int b = 0; b < 2; ++b)
#pragma unroll
            for (int m = 0; m < 4; ++m)
#pragma unroll
                for (int n = 0; n < 2; ++n) acc[a][b][m][n] = (f32x4){0.f, 0.f, 0.f, 0.f};
    bf16x8 At[4][2], B0[2][2], B1[2][2];
    const char* cA = (const char*)g.A + (size_t)cur.pm * tstep; const char* cB = (const char*)g.Bt + (size_t)cur.pn * tstep;
    S.a_ready(cur);
    if constexpr (SP2) {
        PG8_STAGE(PG8_SB(0, 0), cB, voffB); PG8_STAGE(PG8_SB(0, 1), cB + hstep, voffB); PG8_STAGE(PG8_SA(0, 0), cA, voffA); PG8_STAGE(PG8_SA(0, 1), cA + hstep, voffA);
        if (wr == 1) PG8_BAR;
        PG8_WAIT_V(2); PG8_BAR;
        PG8_STAGE(PG8_SB(1, 0), cB + kstep, voffB); PG8_STAGE(PG8_SA(1, 0), cA + kstep, voffA); PG8_STAGE(PG8_SB(1, 1), cB + hstep + kstep, voffB);
        PG8_WAIT_V(6); PG8_BAR;
    } else {
        PG8_STAGE(PG8_SB(0, 0), cB, voffB); PG8_STAGE(PG8_SA(0, 0), cA, voffA); PG8_STAGE(PG8_SB(0, 1), cB + hstep, voffB); PG8_STAGE(PG8_SA(0, 1), cA + hstep, voffA);
        if (wr == 1) PG8_BAR;
        PG8_WAIT_V(4); PG8_BAR;
        PG8_STAGE(PG8_SB(1, 0), cB + kstep, voffB); PG8_STAGE(PG8_SA(1, 0), cA + kstep, voffA); PG8_STAGE(PG8_SB(1, 1), cB + hstep + kstep, voffB);
        PG8_WAIT_V(6); PG8_BAR;
    }
    for (;;) {
        const bool has_next = S.next(ui + 1, nxt);
        const char* nA = has_next ? (const char*)g.A + (size_t)nxt.pm * tstep : cA; const char* nB = has_next ? (const char*)g.Bt + (size_t)nxt.pn * tstep : cB;
        for (int t = 0; t < nt; t += 2) {
            const bool last = (t == nt - 2);
            if constexpr (Epi::HAS_MID) { if (t == E.mid_t) E.mid(acc, cur, wr, wc, fr, fq); }
            const char* a1 = cA + (size_t)(t + 1) * kstep;
            const char* a2 = last ? nA : cA + (size_t)(t + 2) * kstep; const char* b2 = last ? nB : cB + (size_t)(t + 2) * kstep;
            const char* a3 = a2 + kstep; const char* b3 = b2 + kstep;
            if (last && has_next) S.a_ready(nxt);
            if constexpr (SP2) {
            PG8_LDB(B0, 0, 0); PG8_LDB(B1, 0, 1); PG8_SCHED; PG8_LDA(At, 0, 0); PG8_STAGE(PG8_SA(1, 1), a1 + hstep, voffA);
            PG8_WAIT_V(8); PG8_WAIT_L(0); PG8_BAR; PG8_MMA(0, 0, At, B0); PG8_MMA(0, 1, At, B1); PG8_BAR; PG8_SCHED;
            PG8_LDA(At, 0, 1); PG8_STAGE(PG8_SB(0, 0), b2, voffB); PG8_STAGE(PG8_SB(0, 1), b2 + hstep, voffB); PG8_STAGE(PG8_SA(0, 0), a2, voffA);
            PG8_WAIT_V(8); PG8_WAIT_L(0); PG8_BAR; PG8_MMA(1, 0, At, B0); PG8_MMA(1, 1, At, B1); PG8_BAR; PG8_SCHED;
            PG8_LDB(B0, 1, 0); PG8_LDB(B1, 1, 1); PG8_SCHED; PG8_LDA(At, 1, 0); PG8_STAGE(PG8_SA(0, 1), a2 + hstep, voffA);
            PG8_WAIT_V(8); PG8_WAIT_L(0); PG8_BAR; PG8_MMA(0, 0, At, B0); PG8_MMA(0, 1, At, B1); PG8_BAR; PG8_SCHED;
            PG8_LDA(At, 1, 1); PG8_STAGE(PG8_SB(1, 0), b3, voffB); PG8_STAGE(PG8_SB(1, 1), b3 + hstep, voffB); PG8_STAGE(PG8_SA(1, 0), a3, voffA);
            PG8_WAIT_V(8); PG8_WAIT_L(0); PG8_BAR; PG8_MMA(1, 0, At, B0); PG8_MMA(1, 1, At, B1); PG8_BAR; PG8_SCHED;
            } else {
            PG8_LDB(B0, 0, 0); PG8_SCHED; PG8_LDA(At, 0, 0); PG8_STAGE(PG8_SA(1, 1), a1 + hstep, voffA);
            PG8_WAIT_L(8); PG8_BAR; PG8_WAIT_L(0); PG8_MMA(0, 0, At, B0); PG8_BAR; PG8_SCHED;
            PG8_LDB(B1, 0, 1); PG8_STAGE(PG8_SB(0, 0), b2, voffB);
            PG8_BAR; PG8_WAIT_L(0); PG8_MMA(0, 1, At, B1); PG8_BAR;
            PG8_LDA(At, 0, 1); PG8_STAGE(PG8_SA(0, 0), a2, voffA);
            PG8_BAR; PG8_WAIT_L(0); PG8_MMA(1, 0, At, B0); PG8_BAR; PG8_SCHED;
            PG8_STAGE(PG8_SB(0, 1), b2 + hstep, voffB);
            PG8_WAIT_V(6); PG8_BAR; PG8_MMA(1, 1, At, B1); PG8_BAR;
            PG8_LDB(B0, 1, 0); PG8_SCHED; PG8_LDA(At, 1, 0); PG8_STAGE(PG8_SA(0, 1), a2 + hstep, voffA);
            PG8_WAIT_L(8); PG8_BAR; PG8_WAIT_L(0); PG8_MMA(0, 0, At, B0); PG8_BAR; PG8_SCHED;
            PG8_LDB(B1, 1, 1); PG8_STAGE(PG8_SB(1, 0), b3, voffB);
            PG8_BAR; PG8_WAIT_L(0); PG8_MMA(0, 1, At, B1); PG8_BAR;
            PG8_LDA(At, 1, 1); PG8_STAGE(PG8_SA(1, 0), a3, voffA);
            PG8_BAR; PG8_WAIT_L(0); PG8_MMA(1, 0, At, B0); PG8_BAR; PG8_SCHED;
            PG8_STAGE(PG8_SB(1, 1), b3 + hstep, voffB);
            PG8_WAIT_V(6); PG8_BAR; PG8_MMA(1, 1, At, B1); PG8_BAR;
            }
        }
        if constexpr (ALIGN_EPI) { if (wr == 0) PG8_BAR; }
        if constexpr (!Epi::AFTER_DRAIN) { E(acc, cur, wr, wc, fr, fq); S.done(cur); }
        if (!has_next) break;
#pragma unroll
        for (int a = 0; a < 2; ++a)
#pragma unroll
            for (int b = 0; b < 2; ++b)
#pragma unroll
                for (int m = 0; m < 4; ++m)
#pragma unroll
                    for (int n = 0; n < 2; ++n) acc[a][b][m][n] = (f32x4){0.f, 0.f, 0.f, 0.f};
        cur = nxt; cA = nA; cB = nB; ++ui;
        if constexpr (ALIGN_EPI) { if (wr == 1) PG8_BAR; }
    }
    PG8_WAIT_V(0);
    if constexpr (!ALIGN_EPI) { if (wr == 0) PG8_BAR; }
    PG8_BAR;
    if constexpr (Epi::AFTER_DRAIN) { E.fused(acc, cur, wr, wc, fr, fq, lds, wid, lane); S.done(cur); }
#undef PG8_SA
#undef PG8_SB
#undef PG8_STAGE
#undef PG8_LDA
#undef PG8_LDB
#undef PG8_MMA
#undef PG8_WAIT_V
#undef PG8_WAIT_L
#undef PG8_BAR
#undef PG8_SCHED
}
}

namespace att {
using bf16x8 = __attribute__((ext_vector_type(8))) short;
using s16x4 = __attribute__((ext_vector_type(4))) short;
using f32x16 = __attribute__((ext_vector_type(16))) float;
using u32x4 = __attribute__((ext_vector_type(4))) unsigned;
typedef unsigned short bf16_t;
#define SBAR() __builtin_amdgcn_sched_barrier(0)
__device__ __forceinline__ int crow(int r, int hi) { return (r & 3) + 8 * (r >> 2) + 4 * hi; }
constexpr int TILEB = 16384, NTILE = 6, LDS_WS = NTILE * TILEB, LDS_OST = LDS_WS + 8 * 64 * 4, LDS_BYTES = LDS_OST + 8 * 4096;
constexpr float LOG2E = 1.4426950408889634f, C2 = 0.125f * LOG2E;
__device__ __forceinline__ void glds16(const void* gsrc, unsigned lds_dst) { unsigned keep;
    asm volatile("s_mov_b32 %0, m0\n\ts_mov_b32 m0, %2\n\ts_nop 0\n\tglobal_load_lds_dwordx4 %1, off\n\ts_mov_b32 m0, %0" : "=&s"(keep) : "v"(gsrc), "s"(lds_dst) : "memory"); }
typedef float f32x2_t __attribute__((ext_vector_type(2))); typedef __bf16 bf16x2_t __attribute__((ext_vector_type(2)));
__device__ __forceinline__ unsigned cvtpk_s(float lo, float hi) { f32x2_t v = {lo, hi}; bf16x2_t b = __builtin_convertvector(v, bf16x2_t); return __builtin_bit_cast(unsigned, b); }
__device__ __forceinline__ void qkt(f32x16& p0, f32x16& p1, const char* Kslot, const bf16x8* qr, const f32x16& negm, int r32, int hi) {
    const char* kb = Kslot + hi * 1024 + r32 * 16;
#pragma unroll
    for (int d0 = 0; d0 < 4; ++d0) {
        const bf16x8 b0 = *reinterpret_cast<const bf16x8*>(kb + d0 * 2048);
        const bf16x8 b1 = *reinterpret_cast<const bf16x8*>(kb + d0 * 2048 + 512);
        if (d0 == 0) { p0 = __builtin_amdgcn_mfma_f32_32x32x16_bf16(b0, qr[0], negm, 0, 0, 0); p1 = __builtin_amdgcn_mfma_f32_32x32x16_bf16(b1, qr[0], negm, 0, 0, 0); }
        else { p0 = __builtin_amdgcn_mfma_f32_32x32x16_bf16(b0, qr[d0], p0, 0, 0, 0); p1 = __builtin_amdgcn_mfma_f32_32x32x16_bf16(b1, qr[d0], p1, 0, 0, 0); } }
}
__device__ __forceinline__ void pv(f32x16* o, int vb, bf16x8 pa0, bf16x8 pa1, bf16x8 pa2, bf16x8 pa3) {
#pragma unroll
    for (int d0 = 0; d0 < 2; ++d0) { s16x4 lo[4], hi[4];
#pragma unroll
        for (int ks = 0; ks < 4; ++ks) {
            asm volatile("ds_read_b64_tr_b16 %0,%1 offset:%c2" : "=&v"(lo[ks]) : "v"(vb), "i"(d0 * 4096 + ks * 1024) : "memory");
            asm volatile("ds_read_b64_tr_b16 %0,%1 offset:%c2" : "=&v"(hi[ks]) : "v"(vb), "i"(d0 * 4096 + ks * 1024 + 512) : "memory"); }
        asm volatile("s_waitcnt lgkmcnt(0)" ::: "memory"); SBAR();
#define PK(k) (bf16x8){lo[k][0], lo[k][1], lo[k][2], lo[k][3], hi[k][0], hi[k][1], hi[k][2], hi[k][3]}
        o[d0] = __builtin_amdgcn_mfma_f32_32x32x16_bf16(pa0, PK(0), o[d0], 0, 0, 0);
        o[d0] = __builtin_amdgcn_mfma_f32_32x32x16_bf16(pa1, PK(1), o[d0], 0, 0, 0);
        o[d0] = __builtin_amdgcn_mfma_f32_32x32x16_bf16(pa2, PK(2), o[d0], 0, 0, 0);
        o[d0] = __builtin_amdgcn_mfma_f32_32x32x16_bf16(pa3, PK(3), o[d0], 0, 0, 0);
#undef PK
    }
}
__device__ __forceinline__ float wmax(float v) {
#pragma unroll
    for (int o = 1; o < 64; o <<= 1) v = fmaxf(v, __shfl_xor(v, o));
    return v;
}
__device__ __forceinline__ void attn_phase(char* shm, const bf16_t* Q, const bf16_t* K, const bf16_t* V, bf16_t* MIX, float* SSA, const float* sink, const float* qg, const float* kg, int vcu, int G) {
    int tid_o = threadIdx.x; asm volatile("" : "+v"(tid_o)); const int tid = tid_o, lane = tid & 63, r32 = lane & 31, hi = lane >> 5; const int wid = __builtin_amdgcn_readfirstlane(tid >> 6);
    const unsigned lds0 = (unsigned)(uintptr_t)shm;
    float* wsf = (float*)(shm + LDS_WS) + wid * 64;
    const float gqm = wmax(fabsf(qg[lane])), gkm = wmax(fabsf(kg[lane]));
    const float B2 = 8.0f * gqm * gkm * LOG2E * 1.02f;
    const int h4 = wid >> 1, e = wid & 1;
    const int vlane = ((lane >> 4) & 1) * 32 + (lane & 3) * 8 + (4 * hi + ((lane & 15) >> 2)) * 64;
    for (int du = vcu; du < 256; du += G) {
        const int b = du >> 6, g = (du >> 5) & 1, j = du & 31;
        const long rowb = (long)b * 4096;
#pragma unroll
        for (int s = 0; s < NTILE; ++s) { const int tt = 2 * j - 2 + s;
            if (tt >= 0 && tt < 64) {
                const bf16_t* ks = K + (rowb + 64 * tt + lane) * 128 + 64 * g + 8 * wid;
                glds16(ks, (unsigned)__builtin_amdgcn_readfirstlane(lds0 + s * TILEB + wid * 1024));
                const bf16_t* vs = V + (rowb + 64 * tt + 16 * (wid & 3) + (lane >> 2)) * 128 + 64 * g + 32 * (wid >> 2) + 8 * (lane & 3);
                glds16(vs, (unsigned)__builtin_amdgcn_readfirstlane(lds0 + s * TILEB + 8192 + wid * 1024)); } }
        asm volatile("s_waitcnt vmcnt(0)\n\ts_barrier" ::: "memory");
        const int h = 4 * g + h4;
        const float sk2 = sink[h] * LOG2E, m2 = fmaxf(B2, sk2);
#pragma unroll 1
        for (int i = 0; i < 2; ++i) {
            const int qb = 2 * j + i, Qs = 64 * qb + 32 * e;
            bf16x8 qr[4];
#pragma unroll
            for (int d0 = 0; d0 < 4; ++d0) qr[d0] = *reinterpret_cast<const bf16x8*>(Q + (rowb + Qs + r32) * 512 + 64 * h + 16 * d0 + 8 * hi);
            f32x16 o[2]; o[0] = f32x16{}; o[1] = f32x16{}; float lsum = 0.f; f32x16 negm;
#pragma unroll
            for (int r = 0; r < 16; ++r) negm[r] = -m2;
            const int qlim = 32 * e + r32;
#pragma unroll
            for (int k = 0; k < 5; ++k) {
                const int tt = qb - 2 + k;
                if (tt >= 0 && tt < 64) {
                    f32x16 p0, p1;
                    qkt(p0, p1, shm + (i + k) * TILEB, qr, negm, r32, hi);
#pragma unroll
                    for (int r = 0; r < 16; ++r) { p0[r] = __builtin_amdgcn_exp2f(p0[r]); p1[r] = __builtin_amdgcn_exp2f(p1[r]); }
                    if (k == 0) {
#pragma unroll
                        for (int r = 0; r < 16; ++r) { const int kv = crow(r, hi); if (kv < qlim) p0[r] = 0.f; if (kv + 32 < qlim) p1[r] = 0.f; } }
                    if (k == 4) {
#pragma unroll
                        for (int r = 0; r < 16; ++r) { const int kv = crow(r, hi); if (kv > qlim) p0[r] = 0.f; if (kv + 32 > qlim) p1[r] = 0.f; } }
                    float sacc = 0.f;
#pragma unroll
                    for (int r = 0; r < 16; ++r) sacc += p0[r] + p1[r];
                    lsum += sacc;
                    u32x4 pw0, pw1, pw2, pw3;
                    pw0 = (u32x4){cvtpk_s(p0[0], p0[1]), cvtpk_s(p0[2], p0[3]), cvtpk_s(p0[4], p0[5]), cvtpk_s(p0[6], p0[7])};
                    pw1 = (u32x4){cvtpk_s(p0[8], p0[9]), cvtpk_s(p0[10], p0[11]), cvtpk_s(p0[12], p0[13]), cvtpk_s(p0[14], p0[15])};
                    pw2 = (u32x4){cvtpk_s(p1[0], p1[1]), cvtpk_s(p1[2], p1[3]), cvtpk_s(p1[4], p1[5]), cvtpk_s(p1[6], p1[7])};
                    pw3 = (u32x4){cvtpk_s(p1[8], p1[9]), cvtpk_s(p1[10], p1[11]), cvtpk_s(p1[12], p1[13]), cvtpk_s(p1[14], p1[15])};
                    SBAR();
                    pv(o, (int)(lds0 + (i + k) * TILEB + 8192) + vlane, __builtin_bit_cast(bf16x8, pw0), __builtin_bit_cast(bf16x8, pw1), __builtin_bit_cast(bf16x8, pw2), __builtin_bit_cast(bf16x8, pw3));
                }
            }
            { auto rr = __builtin_amdgcn_permlane32_swap(__float_as_uint(lsum), __float_as_uint(lsum), false, false); lsum = __uint_as_float(rr[0]) + __uint_as_float(rr[1]); }
            lsum += __builtin_amdgcn_exp2f(sk2 - m2);
            if (hi == 0) wsf[32 + r32] = lsum; asm volatile("s_waitcnt lgkmcnt(0)" ::: "memory");
            float rli[16];
#pragma unroll
            for (int r = 0; r < 16; ++r) rli[r] = __builtin_amdgcn_rcpf(wsf[32 + crow(r, hi)]);
            bf16_t* stg = (bf16_t*)(shm + LDS_OST) + wid * 2048;
#pragma unroll
            for (int r = 0; r < 16; ++r) { const int orow = crow(r, hi);
#pragma unroll
                for (int d0 = 0; d0 < 2; ++d0) stg[orow * 64 + d0 * 32 + r32] = (bf16_t)(cvtpk_s(o[d0][r] * rli[r], 0.f) & 0xffffu); }
            asm volatile("s_waitcnt lgkmcnt(0)" ::: "memory");
#pragma unroll
            for (int i4 = 0; i4 < 4; ++i4) { const int row = i4 * 8 + (lane >> 3), ch = lane & 7; const u32x4 v = *(const u32x4*)(stg + row * 64 + ch * 8);
                *(u32x4*)(MIX + (rowb + Qs + row) * 1024 + 512 + 64 * h + ch * 8) = v;
                float q = 0.f;
#pragma unroll
                for (int t = 0; t < 4; ++t) { const float a = __uint_as_float(v[t] << 16), c = __uint_as_float(v[t] & 0xffff0000u); q += a * a + c * c; }
                q += __shfl_xor(q, 1); q += __shfl_xor(q, 2); q += __shfl_xor(q, 4);
                if (ch == 0) SSA[(rowb + Qs + row) * 8 + h] = q; }
            asm volatile("s_waitcnt lgkmcnt(0)" ::: "memory");
        }
        asm volatile("s_waitcnt lgkmcnt(0)\n\ts_barrier" ::: "memory");
    }
}

template <int STAGE>
__device__ __forceinline__ void dft_phase(char* shm, const bf16_t* in, void* outp, const bf16_t* DC, const bf16_t* DS, const float* TW, int vcu, int G) {
    int tid_o = threadIdx.x; asm volatile("" : "+v"(tid_o)); const int tid = tid_o, lane = tid & 63, r32 = lane & 31, hi = lane >> 5; const int wid = __builtin_amdgcn_readfirstlane(tid >> 6);
    const unsigned lds0 = (unsigned)(uintptr_t)shm;
    char* wbuf = shm + wid * 8192;
    const int vb = (int)(lds0 + wid * 8192) + (8 * hi + ((lane & 15) >> 2)) * 64 + ((lane >> 4) & 1) * 32 + (lane & 3) * 8;
    bf16x8 fc[2][4], fs[2][4];
#pragma unroll
    for (int mb = 0; mb < 2; ++mb)
#pragma unroll
        for (int ks = 0; ks < 4; ++ks) { fc[mb][ks] = *reinterpret_cast<const bf16x8*>(DC + (32 * mb + r32) * 64 + 16 * ks + 8 * hi); fs[mb][ks] = *reinterpret_cast<const bf16x8*>(DS + (32 * mb + r32) * 64 + 16 * ks + 8 * hi); }
    const int NB = STAGE == 1 ? 4096 : 8192;
    const int gw = vcu * 8 + wid, NW = G * 8;
    const int lrow = lane >> 2, lch = lane & 3;
    for (int nb = gw; nb < NB; nb += NW) {
        u32x4 v[4];
        if (STAGE == 1) { const int b = nb >> 10, s2 = (nb >> 4) & 63, c0 = 32 * (nb & 15);
#pragma unroll
            for (int i = 0; i < 4; ++i) v[i] = *(const u32x4*)(in + ((size_t)(b * 4096 + 64 * (lrow + 16 * i) + s2) * 512 + c0 + 8 * lch)); }
        else { const int bk = nb >> 5, cb = nb & 31;
#pragma unroll
            for (int i = 0; i < 4; ++i) v[i] = *(const u32x4*)(in + ((size_t)(bk * 64 + lrow + 16 * i) * 1024 + 32 * cb + 8 * lch)); }
#pragma unroll
        for (int i = 0; i < 4; ++i) *(u32x4*)(wbuf + (lrow + 16 * i) * 64 + lch * 16) = v[i];
        asm volatile("s_waitcnt lgkmcnt(0)" ::: "memory");
        s16x4 lo[4], hh[4];
#pragma unroll
        for (int ks = 0; ks < 4; ++ks) {
            asm volatile("ds_read_b64_tr_b16 %0,%1 offset:%c2" : "=&v"(lo[ks]) : "v"(vb), "i"(ks * 1024) : "memory");
            asm volatile("ds_read_b64_tr_b16 %0,%1 offset:%c2" : "=&v"(hh[ks]) : "v"(vb), "i"(ks * 1024 + 256) : "memory"); }
        asm volatile("s_waitcnt lgkmcnt(0)" ::: "memory"); SBAR();
        f32x16 ac[2], as[2]; ac[0] = f32x16{}; ac[1] = f32x16{}; as[0] = f32x16{}; as[1] = f32x16{};
#pragma unroll
        for (int ks = 0; ks < 4; ++ks) { const bf16x8 bfr = (bf16x8){lo[ks][0], lo[ks][1], lo[ks][2], lo[ks][3], hh[ks][0], hh[ks][1], hh[ks][2], hh[ks][3]};
#pragma unroll
            for (int mb = 0; mb < 2; ++mb) { ac[mb] = __builtin_amdgcn_mfma_f32_32x32x16_bf16(fc[mb][ks], bfr, ac[mb], 0, 0, 0); as[mb] = __builtin_amdgcn_mfma_f32_32x32x16_bf16(fs[mb][ks], bfr, as[mb], 0, 0, 0); } }
        if (STAGE == 1) { const int b = nb >> 10, s2 = (nb >> 4) & 63, c0 = 32 * (nb & 15); unsigned* out = (unsigned*)outp;
#pragma unroll
            for (int mb = 0; mb < 2; ++mb)
#pragma unroll
                for (int rg = 0; rg < 4; ++rg) { const int k1b = 32 * mb + 8 * rg + 4 * hi;
                    const float4 t0 = *(const float4*)(TW + (size_t)(s2 * 64 + k1b) * 2), t1 = *(const float4*)(TW + (size_t)(s2 * 64 + k1b) * 2 + 4);
                    const float cs[4] = {t0.x, t0.z, t1.x, t1.z}, sn[4] = {t0.y, t0.w, t1.y, t1.w};
#pragma unroll
                    for (int rr = 0; rr < 4; ++rr) { const float yc = ac[mb][4 * rg + rr], ys = as[mb][4 * rg + rr];
                        const float zr = yc * cs[rr] - ys * sn[rr], zi = -(yc * sn[rr] + ys * cs[rr]);
                        out[((size_t)((b * 64 + k1b + rr) * 64 + s2)) * 512 + c0 + r32] = cvtpk_s(zr, zi); } }
        } else { const int bk = nb >> 5, cb = nb & 31, b = bk >> 6, k1 = bk & 63; bf16_t* out = (bf16_t*)outp;
#pragma unroll
            for (int mb = 0; mb < 2; ++mb)
#pragma unroll
                for (int r = 0; r < 16; ++r) { const int k2 = 32 * mb + crow(r, hi);
                    const float t = __shfl_xor(as[mb][r], 1); const float x = ac[mb][r] + ((lane & 1) ? -t : t);
                    out[(size_t)(b * 4096 + 64 * k2 + k1) * 1024 + 32 * cb + r32] = (bf16_t)(cvtpk_s(x, 0.f) & 0xffffu); } }
        asm volatile("s_waitcnt lgkmcnt(0)" ::: "memory");
    }
}
#undef SBAR
}

#ifndef PG8_SP2
#define PG8_SP2 true
#endif
#ifndef PG8_ALIGN
#define PG8_ALIGN true
#endif
constexpr int NWAVES = 8;
constexpr int BATCH = 4, SEQ = 4096, D = 1024, M = BATCH * SEQ, DEPTH = 2;
constexpr int FW = 512, NH = 8, HD = 64, INC = 1280, DFF = 2816, UPC = 5632, HALFFF = 1408;
constexpr size_t MiB = 1u << 20;
constexpr size_t WS_CTL = 0, CTL_ZERO_BYTES = 1 * MiB;
constexpr size_t WS_ROPEC = 1 * MiB, WS_ROPES = WS_ROPEC + 512 * 1024, WS_TW = 2 * MiB, WS_DC = WS_TW + 64 * 1024, WS_DS = WS_DC + 16 * 1024;
constexpr size_t WS_GCT = 3 * MiB;
constexpr size_t WS_WIN = 4 * MiB;
constexpr size_t WS_WF = 9 * MiB;
constexpr size_t WS_WO = 10 * MiB;
constexpr size_t WS_WUP = 14 * MiB;
constexpr size_t WS_WDN = 36 * MiB;
constexpr size_t WS_SSX = 47 * MiB;
constexpr size_t WS_XB = 48 * MiB;
constexpr size_t WS_ACT = 80 * MiB;
constexpr size_t WS_HALO = 168 * MiB;
constexpr size_t WS_U = 80 * MiB, WS_Q = 96 * MiB, WS_K = 112 * MiB, WS_V = 116 * MiB, WS_Z = 120 * MiB, WS_W = 152 * MiB, WS_F = 184 * MiB, WS_MIX = 200 * MiB, WS_SSF = 232 * MiB, WS_SSA = WS_SSF + 512 * 1024;
constexpr size_t WS_END = 256 * MiB;
static_assert(WS_ACT + (size_t)M * DFF * 2 == WS_HALO && WS_HALO + (size_t)64 * 4 * UPC * 4 <= WS_END && WS_XB + (size_t)M * D * 2 == WS_ACT, "d_ws map");
constexpr int CW_TMO = 0, CW_CODE = 1;
constexpr int CW_BAR = 4096;
constexpr int RING_OFF = 0, RING_BYTES = 131072;
constexpr int RS_OFF = 133120;
constexpr int LDSCTL_OFF = 149504, MISC_OFF = LDSCTL_OFF + 320;
constexpr int LDS_BYTES = 153600;
static_assert(att::LDS_BYTES <= RS_OFF && RS_OFF + 15360 <= LDSCTL_OFF && MISC_OFF + 128 <= LDS_BYTES, "LDS map");

#define GAS __attribute__((address_space(1)))
#define LAS __attribute__((address_space(3)))
typedef unsigned short bf16;
typedef unsigned v4u __attribute__((ext_vector_type(4)));
typedef float f32x4 __attribute__((ext_vector_type(4)));
typedef GAS unsigned gu32;
#define RLX_AGENT __ATOMIC_RELAXED, __HIP_MEMORY_SCOPE_AGENT
#define LDS_WAIT() asm volatile("s_waitcnt lgkmcnt(0)" ::: "memory")
#define VM_WAIT() asm volatile("s_waitcnt vmcnt(0)" ::: "memory")
__device__ __forceinline__ unsigned f2bf(float f) { unsigned u = __builtin_bit_cast(unsigned, f); return (u + 0x7fffu + ((u >> 16) & 1u)) >> 16; }
__device__ __forceinline__ unsigned pk2(float lo, float hi) { return f2bf(lo) | (f2bf(hi) << 16); }
__device__ __forceinline__ float bflo(unsigned w) { return __uint_as_float(w << 16); }
__device__ __forceinline__ float bfhi(unsigned w) { return __uint_as_float(w & 0xffff0000u); }
#define XB_TMO      128
#define XB_XCNT(j)  (256  + 64 * (j))
#define XB_XSUB(j)  (1280 + 64 * (j))
#define XB_XGEN(j)  (2304 + 64 * (j))
#define XB_TOP      3328
#define XB_TOPGEN   3392
#define XCD_BAR_WORDS 3456
#define XB_SPIN_CAP (1u << 18)

__device__ __forceinline__ unsigned xb_ld(unsigned* p)              { return __hip_atomic_load(p, __ATOMIC_RELAXED, __HIP_MEMORY_SCOPE_AGENT); }
__device__ __forceinline__ unsigned xb_add(unsigned* p, unsigned v) { return __hip_atomic_fetch_add(p, v, __ATOMIC_RELAXED, __HIP_MEMORY_SCOPE_AGENT); }
__device__ __forceinline__ unsigned xb_xcc_id() { return (unsigned)__builtin_amdgcn_s_getreg((3 << 11) | 20) & 0xFu; }
#define XB_SPIN(cond, bar) do { unsigned _sp = 0; while (cond) { __builtin_amdgcn_s_sleep(1); \
    if ((++_sp & 255u) == 0u) { if (xb_ld(&(bar)[XB_TMO])) break; if (_sp > XB_SPIN_CAP) { atomicAdd(&(bar)[XB_TMO], 1u); break; } } } } while (0)

struct XcdBarrier {
    unsigned* bar; unsigned x;
    volatile LAS unsigned* st;
};

__device__ __forceinline__ XcdBarrier xcd_barrier_post(unsigned* bar, volatile LAS unsigned* st) {
    XcdBarrier b; b.bar = bar; b.x = xb_xcc_id(); b.st = st;
    if (threadIdx.x == 0) (void)xb_add(&bar[XB_XCNT(b.x)], 1u);
    return b;
}
__device__ __forceinline__ void xcd_barrier_complete(unsigned* bar, unsigned x, unsigned& nloc, unsigned& nx) {
    const unsigned G = gridDim.x * gridDim.y * gridDim.z;
    unsigned sum, cnt, mine, sp = 0u;
    for (;;) {
        sum = 0u; cnt = 0u; mine = 0u;
#pragma unroll
        for (unsigned j = 0; j < 16; ++j) { const unsigned c = xb_ld(&bar[XB_XCNT(j)]); sum += c; cnt += (c > 0u) ? 1u : 0u; mine = (j == x) ? c : mine; }
        if (sum == G) break;
        __builtin_amdgcn_s_sleep(1);
        if ((++sp & 255u) == 0u) { if (xb_ld(&bar[XB_TMO])) break; if (sp > XB_SPIN_CAP) { atomicAdd(&bar[XB_TMO], 1u); break; } }
    }
    nloc = mine > 0u ? mine : 1u; nx = cnt > 0u ? cnt : 1u;
}

__device__ __forceinline__ void xcd_barrier(const XcdBarrier& b) {
    asm volatile("s_waitcnt vmcnt(0)" ::: "memory");
    __syncthreads();
    if (threadIdx.x == 0) {
        unsigned* bar = b.bar;
        __builtin_amdgcn_s_waitcnt(0);
        unsigned nloc = b.st[0], nx = b.st[1];
        if (nloc == 0u) { xcd_barrier_complete(bar, b.x, nloc, nx); b.st[0] = nloc; b.st[1] = nx; }
        const unsigned old = xb_add(&bar[XB_XSUB(b.x)], 1u);
        const unsigned gen = old / nloc;
        if (old + 1u == (gen + 1u) * nloc) {
            __builtin_amdgcn_fence(__ATOMIC_RELEASE, "agent");
            asm volatile("s_waitcnt vmcnt(0)" ::: "memory");
            const unsigned og = xb_add(&bar[XB_TOP], 1u);
            const unsigned tg = og / nx;
            if (og + 1u == (tg + 1u) * nx) xb_add(&bar[XB_TOPGEN], 1u);
            else XB_SPIN(xb_ld(&bar[XB_TOPGEN]) == tg, bar);
            __builtin_amdgcn_fence(__ATOMIC_ACQUIRE, "agent");
            xb_add(&bar[XB_XGEN(b.x)], 1u);
            asm volatile("s_waitcnt vmcnt(0)" ::: "memory");
        } else {
            XB_SPIN(xb_ld(&bar[XB_XGEN(b.x)]) == gen, bar);
            __builtin_amdgcn_fence(__ATOMIC_ACQUIRE, "agent");
            asm volatile("s_waitcnt vmcnt(0)" ::: "memory");
        }
    }
    __syncthreads();
}

struct Args { const float* in[16]; float* out; unsigned char* ws; int ph_lo, ph_hi, li, pad; };

__device__ __forceinline__ float wave_sum(float v) {
#pragma unroll
    for (int o = 1; o < 64; o <<= 1) v += __shfl_xor(v, o);
    return v;
}
__device__ __forceinline__ void tr_item(const float* W, int K, int N, const float* gain, bf16* WT, int out_row0, LAS float* scr, int k0, int n0, int lane) {
#pragma unroll 8
    for (int i = 0; i < 32; ++i) { const int kk = 2 * i + (lane >> 5); const float gv = gain ? gain[k0 + kk] : 1.0f; scr[kk * 33 + (lane & 31)] = W[(size_t)(k0 + kk) * N + n0 + (lane & 31)] * gv; }
    LDS_WAIT(); asm volatile("" ::: "memory");
    const int c = lane & 7;
#pragma unroll
    for (int j = 0; j < 4; ++j) { const int n = (lane >> 3) + 8 * j; const LAS float* s = scr + (8 * c) * 33 + n;
        v4u o; o.x = pk2(s[0 * 33], s[1 * 33]); o.y = pk2(s[2 * 33], s[3 * 33]); o.z = pk2(s[4 * 33], s[5 * 33]); o.w = pk2(s[6 * 33], s[7 * 33]);
        *(GAS v4u*)(WT + (size_t)(out_row0 + n) * K + k0 + 8 * c) = o; }
    LDS_WAIT(); asm volatile("" ::: "memory");
}
__device__ __forceinline__ int win_pos(int n0) { if (n0 < 512) return n0; const int t = n0 - 512, slot = t >> 6, bj = (t >> 5) & 1; return 256 * (2 + (slot >> 2)) + 128 * bj + 32 * (slot & 3); }
__device__ __forceinline__ int wup_pos(int n0) { if (n0 < DFF) return 256 * (n0 >> 7) + (n0 & 127); const int t = n0 - DFF; return 256 * (t >> 7) + 128 + (t & 127); }

struct PArgs { const float *x, *norm1, *w_in, *w_f, *g_f, *g_a, *w_o, *norm2, *w_up, *w_down; float* out; unsigned char* ws; };
__device__ __forceinline__ void p0_prologue(const PArgs& P, LAS unsigned char* lds, int vcu, int G, int wave, int lane, int tid) {
    LAS float* scr = (LAS float*)(lds + RING_OFF + wave * 16384);
    const int gw = vcu * NWAVES + wave, NGW = G * NWAVES;
    unsigned char* ws = P.ws;
    constexpr int I_IN = (D / 64) * (INC / 32), I_F = (FW / 64) * (FW / 32), I_O = (D / 64) * (D / 32), I_UP = (D / 64) * (UPC / 32), I_DN = (DFF / 64) * (D / 32);
    constexpr int I_LAYER = I_IN + I_F + I_O + I_UP + I_DN;
    for (int it = gw; it < DEPTH * I_LAYER; it += NGW) {
        const int l = it / I_LAYER; int r = it - l * I_LAYER;
        if (r < I_IN) { const int nblk = INC / 32, k0 = 64 * (r / nblk), n0 = 32 * (r % nblk);
            tr_item(P.w_in + (size_t)l * D * INC, D, INC, P.norm1 + l * D, (bf16*)(ws + WS_WIN) + (size_t)l * INC * D, win_pos(n0), scr, k0, n0, lane); continue; } r -= I_IN;
        if (r < I_F) { const int nblk = FW / 32, k0 = 64 * (r / nblk), n0 = 32 * (r % nblk);
            tr_item(P.w_f + (size_t)l * FW * FW, FW, FW, nullptr, (bf16*)(ws + WS_WF) + (size_t)l * FW * FW, n0, scr, k0, n0, lane); continue; } r -= I_F;
        if (r < I_O) { const int nblk = D / 32, k0 = 64 * (r / nblk), n0 = 32 * (r % nblk);
            const float* gain = (k0 < FW) ? (P.g_f + l * FW) : (P.g_a + l * FW - FW);
            tr_item(P.w_o + (size_t)l * D * D, D, D, gain, (bf16*)(ws + WS_WO) + (size_t)l * D * D, n0, scr, k0, n0, lane); continue; } r -= I_O;
        if (r < I_UP) { const int nblk = UPC / 32, k0 = 64 * (r / nblk), n0 = 32 * (r % nblk);
            tr_item(P.w_up + (size_t)l * D * UPC, D, UPC, P.norm2 + l * D, (bf16*)(ws + WS_WUP) + (size_t)l * UPC * D, wup_pos(n0), scr, k0, n0, lane); continue; } r -= I_UP;
        { const int nblk = D / 32, k0 = 64 * (r / nblk), n0 = 32 * (r % nblk);
            tr_item(P.w_down + (size_t)l * DFF * D, DFF, D, nullptr, (bf16*)(ws + WS_WDN) + (size_t)l * D * DFF, n0, scr, k0, n0, lane); }
    }
    const int gt = vcu * (NWAVES * 64) + tid, NGT = G * NWAVES * 64;
    { float* rc = (float*)(ws + WS_ROPEC); float* rs = (float*)(ws + WS_ROPES);
      for (int i = gt; i < SEQ * 32; i += NGT) { const int pos = i >> 5, f = i & 31; const float inv_freq = 1.0f / powf(10000.0f, (float)(2 * f) / 64.0f); const float ang = (float)pos * inv_freq;
          float s, c; sincosf(ang, &s, &c); rc[i] = c; rs[i] = s; } }
    { float* tw = (float*)(ws + WS_TW);
      for (int i = gt; i < 64 * 64; i += NGT) { const int s2 = i >> 6, k1 = i & 63; const float a = (float)((k1 * s2) & 4095) * (2.0f / 4096.0f); tw[2 * i] = cospif(a); tw[2 * i + 1] = sinpif(a); } }
    { bf16* dc = (bf16*)(ws + WS_DC); bf16* ds = (bf16*)(ws + WS_DS);
      for (int i = gt; i < 64 * 64; i += NGT) { const int a = i >> 6, b2 = i & 63; const float t = (float)((a * b2) & 63) * (2.0f / 64.0f); dc[i] = (bf16)f2bf(cospif(t) * 0.125f); ds[i] = (bf16)f2bf(sinpif(t) * 0.125f); } }
    { bf16* gct = (bf16*)(ws + WS_GCT);
      const float sc = 0.04419417382415922f;
      for (int i = gt; i < FW * FW; i += NGT) { const int n = i >> 9, c = i & 511; const float t = (float)((c * n) & 511) * (2.0f / 512.0f);
          ((unsigned*)gct)[i] = pk2(cospif(t) * sc, sinpif(t) * sc); } }
    for (int m = gw; m < M; m += NGW) {
        const GAS f32x4* xr = (const GAS f32x4*)(P.x + (size_t)m * D) + lane;
        GAS unsigned long long* o8 = (GAS unsigned long long*)((bf16*)(ws + WS_XB) + (size_t)m * D) + lane;
        float s = 0.f;
#pragma unroll
        for (int j = 0; j < 4; ++j) { const f32x4 v = xr[64 * j]; ((GAS f32x4*)(P.out + (size_t)m * D) + lane)[64 * j] = v; s += (v.x * v.x + v.y * v.y) + (v.z * v.z + v.w * v.w);
            o8[64 * j] = (unsigned long long)pk2(v.x, v.y) | ((unsigned long long)pk2(v.z, v.w) << 32); }
        s += __shfl_xor(s, 1); s += __shfl_xor(s, 2);
        if ((lane & 3) == 0) ((float*)(ws + WS_SSX))[(size_t)m * 16 + (lane >> 2)] = s;
    }
}

__device__ __forceinline__ void act_fixup(const float* HALO, bf16* ACT, const float* cw, const float* cb, int pm, int tid) {
    for (int idx = tid; idx < 2 * DFF; idx += NWAVES * 64) {
        const int which = idx >= DFF ? 1 : 0, c = idx - which * DFF;
        const int pos = 256 * (c >> 7) + (c & 127);
        const float* hc = HALO + (size_t)(pm * 4) * UPC + pos;
        float pg, pv_, cg, cv, ng, nv;
        if (which == 0) { const bool ok = (pm & 15) != 0; const float* hp = HALO + (size_t)((pm - 1) * 4 + 3) * UPC + pos;
            pg = ok ? hp[0] : 0.f; pv_ = ok ? hp[128] : 0.f; cg = hc[0]; cv = hc[128]; ng = hc[UPC]; nv = hc[UPC + 128]; }
        else { const bool ok = (pm & 15) != 15; const float* hn = HALO + (size_t)((pm + 1) * 4) * UPC + pos;
            pg = hc[2 * UPC]; pv_ = hc[2 * UPC + 128]; cg = hc[3 * UPC]; cv = hc[3 * UPC + 128]; ng = ok ? hn[0] : 0.f; nv = ok ? hn[128] : 0.f; }
        const float g = cb[c] + cw[c] * pg + cw[UPC + c] * cg + cw[2 * UPC + c] * ng;
        const float v = cb[DFF + c] + cw[DFF + c] * pv_ + cw[UPC + DFF + c] * cv + cw[2 * UPC + DFF + c] * nv;
        const float o = g / (1.0f + __expf(-g)) * v;
        ACT[(size_t)(pm * 256 + which * 255) * DFF + c] = (bf16)f2bf(o);
    }
}

constexpr int PH_PER_LAYER = 8, N_PHASES = 1 + DEPTH * PH_PER_LAYER;
typedef __attribute__((address_space(4))) const Args CArgs;
#define KARGS(A) CArgs* A = (CArgs*)__builtin_amdgcn_kernarg_segment_ptr(); asm volatile("" : "+s"(A))
#define OPAQUE_TID(t) int t = threadIdx.x; asm volatile("" : "+v"(t))
__global__ void __launch_bounds__(NWAVES * 64, 2) mk_fwd(Args args_unused) {
    extern __shared__ __attribute__((aligned(16))) unsigned char lds[];
    LAS unsigned char* ldsl = (LAS unsigned char*)lds;
    const int G = gridDim.x; int vcu; { const int bx = blockIdx.x; vcu = (G % 8 == 0) ? (bx % 8) * (G / 8) + bx / 8 : bx; }
    XcdBarrier bar; int lo, hi;
    { KARGS(A); OPAQUE_TID(tid);
      for (int u = tid; u < (LDS_BYTES - LDSCTL_OFF) / 4; u += NWAVES * 64) ((LAS unsigned*)(ldsl + LDSCTL_OFF))[u] = 0u;
      __syncthreads();
      bar = xcd_barrier_post((unsigned*)(A->ws + WS_CTL) + CW_BAR + A->li * XCD_BAR_WORDS, (volatile LAS unsigned*)(ldsl + MISC_OFF) + 8);
      lo = A->ph_lo; hi = A->ph_hi; }
#define IN(k) (lo <= (k) && (k) < hi)
#define SEAM(k) do { if (IN((k) + 1)) xcd_barrier(bar); } while (0)

    if (IN(0)) { KARGS(A); OPAQUE_TID(tid); const int lane = tid & 63, wave = __builtin_amdgcn_readfirstlane(tid >> 6);
        PArgs P{A->in[0], A->in[1], A->in[2], A->in[3], A->in[8], A->in[9], A->in[10], A->in[11], A->in[12], A->in[15], A->out, A->ws}; p0_prologue(P, ldsl, vcu, G, wave, lane, tid); SEAM(0); }

#pragma unroll 1
    for (int l = 0; l < DEPTH; ++l) {
        const int pb = 1 + l * PH_PER_LAYER;
        if (IN(pb + 0)) { KARGS(A); unsigned char* ws = A->ws;
            pg8::Gemm g{(const bf16*)(ws + WS_XB), (const bf16*)(ws + WS_WIN) + (size_t)l * INC * D, M, INC, D}; pg8::StaticOrder S; S.init(M, INC, G, (int)blockIdx.x);
            pg8::EpiIn E{(bf16*)(ws + WS_U), (bf16*)(ws + WS_Q), (bf16*)(ws + WS_K), (bf16*)(ws + WS_V), (const float*)(ws + WS_SSX), (const float*)(ws + WS_ROPEC), (const float*)(ws + WS_ROPES), A->in[5] + l * HD, A->in[6] + l * HD, att::C2, -1};
            pg8::gemm_phase<pg8::EpiIn, pg8::StaticOrder, PG8_ALIGN, PG8_SP2>(ldsl + RING_OFF, g, S, E);
            SEAM(pb + 0);
        }
        if (IN(pb + 1)) { KARGS(A); unsigned char* ws = A->ws;
            att::attn_phase((char*)lds, (const bf16*)(ws + WS_Q), (const bf16*)(ws + WS_K), (const bf16*)(ws + WS_V), (bf16*)(ws + WS_MIX), (float*)(ws + WS_SSA), A->in[7] + l * NH, A->in[5] + l * HD, A->in[6] + l * HD, vcu, G);
            att::dft_phase<1>((char*)lds, (const bf16*)(ws + WS_U), (void*)(ws + WS_Z), (const bf16*)(ws + WS_DC), (const bf16*)(ws + WS_DS), (const float*)(ws + WS_TW), vcu, G);
            SEAM(pb + 1);
        }
        if (IN(pb + 2)) { KARGS(A); unsigned char* ws = A->ws;
            att::dft_phase<2>((char*)lds, (const bf16*)(ws + WS_Z), (void*)(ws + WS_W), (const bf16*)(ws + WS_DC), (const bf16*)(ws + WS_DS), (const float*)(ws + WS_TW), vcu, G);
            SEAM(pb + 2);
        }
        if (IN(pb + 3)) { KARGS(A); unsigned char* ws = A->ws;
            pg8::Gemm g{(const bf16*)(ws + WS_W), (const bf16*)(ws + WS_GCT), M, FW, D}; pg8::StaticOrder S; S.init(M, FW, G, (int)blockIdx.x);
            typedef pg8::EpiStd<false, false, false> E_t; E_t E{(bf16*)(ws + WS_F), FW, nullptr, nullptr, nullptr, 0, -1};
            pg8::gemm_phase<E_t, pg8::StaticOrder, PG8_ALIGN, PG8_SP2>(ldsl + RING_OFF, g, S, E);
            SEAM(pb + 3);
        }
        if (IN(pb + 4)) { KARGS(A); unsigned char* ws = A->ws;
            pg8::Gemm g{(const bf16*)(ws + WS_F), (const bf16*)(ws + WS_WF) + (size_t)l * FW * FW, M, FW, FW}; pg8::StaticOrder S; S.init(M, FW, G, (int)blockIdx.x);
            typedef pg8::EpiStd<false, true, true> E_t; E_t E{(bf16*)(ws + WS_MIX), D, nullptr, A->in[4] + l * FW, (float*)(ws + WS_SSF), 8, -1};
            pg8::gemm_phase<E_t, pg8::StaticOrder, PG8_ALIGN, PG8_SP2>(ldsl + RING_OFF, g, S, E);
            SEAM(pb + 4);
        }
        if (IN(pb + 5)) { KARGS(A); unsigned char* ws = A->ws;
            pg8::StaticOrder S; S.init(M, D, G, (int)blockIdx.x);
            LAS float* rs_tab = (LAS float*)(ldsl + RS_OFF);
            pg8::Unit u;
            for (int i = 0; S.next(i, u); ++i) {
                { OPAQUE_TID(tid); const int row = tid >> 1, which = tid & 1; const float* sp = (const float*)(ws + (which ? WS_SSA : WS_SSF)) + (size_t)(u.pm * 256 + row) * 8;
                  const f32x4 a = *(const f32x4*)sp, b = *(const f32x4*)(sp + 4); const float ss = ((a[0] + a[1]) + (a[2] + a[3])) + ((b[0] + b[1]) + (b[2] + b[3]));
                  const float r = 1.0f / sqrtf(ss * (1.0f / 512.0f) + 1e-6f); const float ro = __shfl_xor(r, 1);
                  if (which == 0) rs_tab[row * 2] = r / ro; else rs_tab[row * 2 + 1] = r; }
                LDS_WAIT(); __syncthreads();
                pg8::Gemm g{(const bf16*)(ws + WS_MIX), (const bf16*)(ws + WS_WO) + (size_t)l * D * D, M, D, D}; pg8::OneUnit S1{u};
                typedef pg8::EpiRes<true> E_t; E_t E{(const float*)A->out, A->out, (bf16*)(ws + WS_XB), (float*)(ws + WS_SSX), rs_tab, 8};
                pg8::gemm_phase<E_t, pg8::OneUnit, false, PG8_SP2>(ldsl + RING_OFF, g, S1, E);
                __syncthreads();
            }
            SEAM(pb + 5);
        }
        if (IN(pb + 6)) { KARGS(A); unsigned char* ws = A->ws;
            pg8::Gemm g{(const bf16*)(ws + WS_XB), (const bf16*)(ws + WS_WUP) + (size_t)l * UPC * D, M, UPC, D}; pg8::StaticOrder S; S.init(M, UPC, G, (int)blockIdx.x);
            pg8::EpiUpConv E{(bf16*)(ws + WS_ACT), (const float*)(ws + WS_SSX), A->in[13] + (size_t)l * 3 * UPC, A->in[14] + (size_t)l * UPC, (float*)(ws + WS_HALO), (LAS float*)(ldsl + RS_OFF), -1};
            pg8::gemm_phase<pg8::EpiUpConv, pg8::StaticOrder, true, PG8_SP2>(ldsl + RING_OFF, g, S, E);
            SEAM(pb + 6);
        }
        if (IN(pb + 7)) { KARGS(A); unsigned char* ws = A->ws;
            pg8::StaticOrder S; S.init(M, D, G, (int)blockIdx.x);
            { OPAQUE_TID(tid); pg8::Unit u; for (int i = 0; S.next(i, u); ++i) act_fixup((const float*)(ws + WS_HALO), (bf16*)(ws + WS_ACT), A->in[13] + (size_t)l * 3 * UPC, A->in[14] + (size_t)l * UPC, u.pm, tid); }
            VM_WAIT(); __syncthreads();
            pg8::Gemm g{(const bf16*)(ws + WS_ACT), (const bf16*)(ws + WS_WDN) + (size_t)l * D * DFF, M, D, DFF};
            typedef pg8::EpiRes<false> E_t; E_t E{A->out, A->out, (bf16*)(ws + WS_XB), (float*)(ws + WS_SSX), nullptr, -1};
            pg8::gemm_phase<E_t, pg8::StaticOrder, PG8_ALIGN, PG8_SP2>(ldsl + RING_OFF, g, S, E);
            SEAM(pb + 7);
        }
    }
#undef IN
#undef SEAM
}

extern "C" void kernel_launch(void* const* d_in, const int* in_sizes, int n_in, void* d_out, int out_size, void* d_ws, size_t ws_size, hipStream_t stream) {
    static int grid = 0;
    if (grid == 0) {
        if (n_in != 16 || in_sizes[0] != M * D || out_size != M * D || ws_size < WS_END) { fprintf(stderr, "kernel_launch: unexpected shapes (n_in %d, in0 %d, out %d, ws %zu); nothing launched\n", n_in, n_in > 0 ? in_sizes[0] : -1, out_size, ws_size); grid = -1; return; }
        int dev = 0, cus = 0, per_cu = 0;
        if (hipGetDevice(&dev) != hipSuccess || hipDeviceGetAttribute(&cus, hipDeviceAttributeMultiprocessorCount, dev) != hipSuccess) { grid = -1; return; }
        if (hipFuncSetAttribute((const void*)mk_fwd, hipFuncAttributeMaxDynamicSharedMemorySize, LDS_BYTES) != hipSuccess) { fprintf(stderr, "kernel_launch: hipFuncSetAttribute failed\n"); grid = -1; return; }
        if (hipOccupancyMaxActiveBlocksPerMultiprocessor(&per_cu, (const void*)mk_fwd, NWAVES * 64, LDS_BYTES) != hipSuccess || per_cu < 1) { fprintf(stderr, "kernel_launch: occupancy query says %d blocks per CU; nothing launched\n", per_cu); (void)hipGetLastError(); grid = -1; return; }
        grid = cus;
    }
    if (grid < 0) return;
    (void)hipMemsetAsync((char*)d_ws + WS_CTL, 0, CTL_ZERO_BYTES, stream);
    Args a{};
    for (int i = 0; i < 16; ++i) a.in[i] = (const float*)d_in[i];
    a.out = (float*)d_out; a.ws = (unsigned char*)d_ws;
#ifndef MK_CUTS
    a.ph_lo = 0; a.ph_hi = N_PHASES; a.li = 0;
    hipLaunchKernelGGL(mk_fwd, dim3(grid), dim3(NWAVES * 64), LDS_BYTES, stream, a);
#else
    { const int cuts[] = {MK_CUTS}; const int nc = (int)(sizeof(cuts) / sizeof(int)); int lo = 0;
      for (int li = 0; li <= nc; ++li) { const int hi = li < nc ? cuts[li] : N_PHASES; a.ph_lo = lo; a.ph_hi = hi; a.li = li; hipLaunchKernelGGL(mk_fwd, dim3(grid), dim3(NWAVES * 64), LDS_BYTES, stream, a); lo = hi; } }
#endif
}
```
